# Optimizing an MI355X kernel written in HIP

```python
import math
import jax
import jax.numpy as jnp
from jax import lax
import numpy as np

D_MODEL = 1024
BATCH = 8
SEQ = 2048
DEPTH = 4
DEC_BATCH = 8
DEC_SEQ = 16
PAST_LEN = 2048

CHUNK = 64
Q_BLOCK = 128
A_HEADS = 8
NOPE_DIM = 64
ROPE_DIM = 32
V_DIM = 64
Q_LORA = 384
KV_LORA = 256
ROPE_THETA = 10000.0
W_A = A_HEADS * V_DIM
SM_SCALE = (NOPE_DIM + ROPE_DIM) ** -0.5
C_B = 256
CONV_B_WIDTH = 31
C_C = 256
C_GROUPS = 4
GMLP_CHUNK = 128
C_D = 256
CONV_D_WIDTH = 3
N_BRANCH = 4
D_FF = 2816
EPS = 1e-6
O_Q = Q_LORA
O_KV = O_Q + KV_LORA
O_KR = O_KV + ROPE_DIM
O_B = O_KR + 2 * C_B
O_C = O_B + 2 * C_C
O_D = O_C + 3 * C_D
D_IN = O_D + N_BRANCH * D_MODEL

kernel_name = 'hybrid_mla_conformer_gmlp_shortconv_stream_step'


def rmsnorm(x, g):
    xf = x.astype(jnp.float32)
    xf = xf * lax.rsqrt(jnp.mean(jnp.square(xf), axis=-1, keepdims=True) + EPS)
    return (xf * g.astype(jnp.float32)).astype(x.dtype)


def layernorm(x, g, b):
    xf = x.astype(jnp.float32)
    mu = jnp.mean(xf, axis=-1, keepdims=True)
    var = jnp.mean(jnp.square(xf - mu), axis=-1, keepdims=True)
    y = (xf - mu) * lax.rsqrt(var + EPS)
    return (y * g.astype(jnp.float32) + b.astype(jnp.float32)).astype(x.dtype)


def rope_tables(pos):
    half = ROPE_DIM // 2
    inv = jnp.exp(-math.log(ROPE_THETA) * jnp.arange(half, dtype=jnp.float32) / half)
    ang = pos.astype(jnp.float32)[:, None] * inv[None, :]
    return jnp.cos(ang), jnp.sin(ang)


def apply_rope(x, cos, sin):
    x1, x2 = jnp.split(x, 2, axis=-1)
    cos = cos.astype(x.dtype)
    sin = sin.astype(x.dtype)
    return jnp.concatenate([x1 * cos - x2 * sin, x2 * cos + x1 * sin], axis=-1)


def causal_dwconv(xpad, w):
    return lax.conv_general_dilated(
        xpad, w[:, None, :].astype(xpad.dtype), window_strides=(1,), padding='VALID',
        dimension_numbers=('NWC', 'WIO', 'NWC'), feature_group_count=xpad.shape[-1])


def swiglu_ffn(x, g_pre, g_post, w_gu, w_down):
    gate, up = jnp.split(rmsnorm(x, g_pre) @ w_gu, 2, axis=-1)
    return rmsnorm((jax.nn.silu(gate) * up) @ w_down, g_post)


def mla_expand(latent, w_ukv):
    b, l = latent.shape[:2]
    kv = (latent @ w_ukv).reshape(b, l, A_HEADS, NOPE_DIM + V_DIM)
    return kv[..., :NOPE_DIM], kv[..., NOPE_DIM:]


def mla_scores(q_nope, q_rope, k_nope, k_rope):
    s = (jnp.einsum('bqhd,bkhd->bhqk', q_nope, k_nope)
         + jnp.einsum('bqhr,bkr->bhqk', q_rope, k_rope))
    return s.astype(jnp.float32) * SM_SCALE


def mla_prompt(q_nope, q_rope, latent, k_rope, w_ukv):
    b, s = q_nope.shape[:2]
    nb = s // Q_BLOCK
    k_nope, v = mla_expand(latent, w_ukv)
    key_chunk = jnp.arange(s) // CHUNK
    qn = q_nope.reshape(b, nb, Q_BLOCK, A_HEADS, NOPE_DIM).swapaxes(0, 1)
    qr = q_rope.reshape(b, nb, Q_BLOCK, A_HEADS, ROPE_DIM).swapaxes(0, 1)

    def block(args):
        qn_b, qr_b, i = args
        q_chunk = (i * Q_BLOCK + jnp.arange(Q_BLOCK)) // CHUNK
        sc = mla_scores(qn_b, qr_b, k_nope, k_rope)
        sc = jnp.where(key_chunk[None, :] <= q_chunk[:, None], sc, -jnp.inf)
        prob = jax.nn.softmax(sc, axis=-1).astype(v.dtype)
        return jnp.einsum('bhqk,bkhd->bqhd', prob, v)

    o = lax.map(block, (qn, qr, jnp.arange(nb)))
    return o.swapaxes(0, 1).reshape(b, s, W_A)


def mla_sample(q_nope, q_rope, lat_all, kr_all, w_ukv):
    b, t = q_nope.shape[:2]
    k_nope, v = mla_expand(lat_all, w_ukv)
    prob = jax.nn.softmax(mla_scores(q_nope, q_rope, k_nope, kr_all), axis=-1).astype(v.dtype)
    return jnp.einsum('bhqk,bkhd->bqhd', prob, v).reshape(b, t, W_A)


def gmlp_mask():
    ar = jnp.arange(GMLP_CHUNK) // CHUNK
    return ar[None, :] <= ar[:, None]


def spatial_mix_prompt(v, w_s, b_s):
    b, s, _ = v.shape
    w = jnp.where(gmlp_mask()[None], w_s, 0.0).astype(v.dtype)
    vr = v.reshape(b, s // GMLP_CHUNK, GMLP_CHUNK, C_GROUPS, C_C // C_GROUPS)
    out = jnp.einsum('gij,bnjgc->bnigc', w, vr) + b_s.T[:, :, None]
    return out.reshape(b, s, C_C)


def spatial_mix_sample(v, w_s, b_s):
    b, t, _ = v.shape
    w = jnp.where(gmlp_mask()[None], w_s, 0.0).astype(v.dtype)[:, :t, :t]
    vr = v.reshape(b, t, C_GROUPS, C_C // C_GROUPS)
    out = jnp.einsum('gij,bjgc->bigc', w, vr) + b_s[:, :t].T[:, :, None]
    return out.reshape(b, t, C_C)


def token_mixer(n, cos, sin, p, cache_lat, cache_kr, buf_b, buf_d):
    b, t, _ = n.shape
    h = n @ p['w_in']
    cq, ckv, kr, glu_in, uv, dproj, g = jnp.split(h, [O_Q, O_KV, O_KR, O_B, O_C, O_D], axis=-1)

    q = (rmsnorm(cq, p['q_norm']) @ p['w_uq']).reshape(b, t, A_HEADS, NOPE_DIM + ROPE_DIM)
    q_nope = q[..., :NOPE_DIM]
    q_rope = apply_rope(q[..., NOPE_DIM:], cos[:, None], sin[:, None])
    latent = rmsnorm(ckv, p['kv_norm'])
    k_rope = apply_rope(kr, cos, sin)
    if cache_lat is None:
        a = mla_prompt(q_nope, q_rope, latent, k_rope, p['w_ukv'])
    else:
        a = mla_sample(q_nope, q_rope,
                       jnp.concatenate([cache_lat.astype(latent.dtype), latent], axis=1),
                       jnp.concatenate([cache_kr.astype(k_rope.dtype), k_rope], axis=1),
                       p['w_ukv'])

    ga, gg = jnp.split(glu_in, 2, axis=-1)
    xb = ga * jax.nn.sigmoid(gg)
    bpad = jnp.concatenate([buf_b.astype(xb.dtype), xb], axis=1)
    yb = causal_dwconv(bpad, p['conv_b_w']) + p['conv_b_bias']
    yb = jax.nn.silu(layernorm(yb, p['conv_b_ln_g'], p['conv_b_ln_b']))
    new_b = bpad[:, -(CONV_B_WIDTH - 1):]

    u, v = jnp.split(uv, 2, axis=-1)
    v = layernorm(v, p['gmlp_vn_g'], p['gmlp_vn_b'])
    if cache_lat is None:
        yc = u * spatial_mix_prompt(v, p['gmlp_w_s'], p['gmlp_b_s'])
    else:
        yc = u * spatial_mix_sample(v, p['gmlp_w_s'], p['gmlp_b_s'])

    bg, cg, hd = jnp.split(dproj, 3, axis=-1)
    xd = cg * hd
    dpad = jnp.concatenate([buf_d.astype(xd.dtype), xd], axis=1)
    yd = bg * causal_dwconv(dpad, p['conv_d_w'])
    new_d = dpad[:, -(CONV_D_WIDTH - 1):]

    gates = jax.nn.sigmoid(g).reshape(b, t, N_BRANCH, D_MODEL)
    merged = (gates[:, :, 0] * (a @ p['w_br_a']) + gates[:, :, 1] * (yb @ p['w_br_b'])
              + gates[:, :, 2] * (yc @ p['w_br_c']) + gates[:, :, 3] * (yd @ p['w_br_d']))
    return merged @ p['w_o'], (latent, k_rope, new_b, v, new_d)


def setup_inputs(seed: int = 0) -> dict:
    key = jax.random.key(seed)
    ks = iter(jax.random.split(key, 64))

    def nrm(shape, scale):
        return scale * jax.random.normal(next(ks), shape, jnp.float32)

    def gain(shape):
        return 1.0 + nrm(shape, 0.05)

    L = DEPTH
    return {
        'x_prompt': nrm((BATCH, SEQ, D_MODEL), 1.0),
        'x_sample': nrm((DEC_BATCH, DEC_SEQ, D_MODEL), 1.0),
        'cache_kv_latent': nrm((L, DEC_BATCH, PAST_LEN, KV_LORA), 1.0),
        'cache_k_rope': nrm((L, DEC_BATCH, PAST_LEN, ROPE_DIM), 1.0),
        'state_conv_b': nrm((L, DEC_BATCH, CONV_B_WIDTH - 1, C_B), 0.5),
        'state_conv_d': nrm((L, DEC_BATCH, CONV_D_WIDTH - 1, C_D), 0.5),
        'ffn1_norm_pre': gain((L, D_MODEL)),
        'ffn1_norm_post': gain((L, D_MODEL)),
        'ffn1_w_gu': nrm((L, D_MODEL, 2 * D_FF), D_MODEL ** -0.5),
        'ffn1_w_down': nrm((L, D_FF, D_MODEL), D_FF ** -0.5),
        'mix_norm_pre': gain((L, D_MODEL)),
        'mix_norm_post': gain((L, D_MODEL)),
        'w_in': nrm((L, D_MODEL, D_IN), D_MODEL ** -0.5),
        'q_norm': gain((L, Q_LORA)),
        'w_uq': nrm((L, Q_LORA, A_HEADS * (NOPE_DIM + ROPE_DIM)), Q_LORA ** -0.5),
        'kv_norm': gain((L, KV_LORA)),
        'w_ukv': nrm((L, KV_LORA, A_HEADS * (NOPE_DIM + V_DIM)), KV_LORA ** -0.5),
        'conv_b_w': nrm((L, CONV_B_WIDTH, C_B), CONV_B_WIDTH ** -0.5),
        'conv_b_bias': nrm((L, C_B), 0.02),
        'conv_b_ln_g': gain((L, C_B)),
        'conv_b_ln_b': nrm((L, C_B), 0.02),
        'gmlp_vn_g': gain((L, C_C)),
        'gmlp_vn_b': nrm((L, C_C), 0.02),
        'gmlp_w_s': nrm((L, C_GROUPS, GMLP_CHUNK, GMLP_CHUNK), GMLP_CHUNK ** -0.5),
        'gmlp_b_s': 1.0 + nrm((L, C_GROUPS, GMLP_CHUNK), 0.1),
        'conv_d_w': nrm((L, CONV_D_WIDTH, C_D), CONV_D_WIDTH ** -0.5),
        'w_br_a': nrm((L, W_A, D_MODEL), W_A ** -0.5),
        'w_br_b': nrm((L, C_B, D_MODEL), C_B ** -0.5),
        'w_br_c': nrm((L, C_C, D_MODEL), C_C ** -0.5),
        'w_br_d': nrm((L, C_D, D_MODEL), C_D ** -0.5),
        'w_o': nrm((L, D_MODEL, D_MODEL), D_MODEL ** -0.5),
        'ffn2_norm_pre': gain((L, D_MODEL)),
        'ffn2_norm_post': gain((L, D_MODEL)),
        'ffn2_w_gu': nrm((L, D_MODEL, 2 * D_FF), D_MODEL ** -0.5),
        'ffn2_w_down': nrm((L, D_FF, D_MODEL), D_FF ** -0.5),
    }


def reference(x_prompt, x_sample, cache_kv_latent, cache_k_rope, state_conv_b, state_conv_d,
              ffn1_norm_pre, ffn1_norm_post, ffn1_w_gu, ffn1_w_down,
              mix_norm_pre, mix_norm_post, w_in, q_norm, w_uq, kv_norm, w_ukv,
              conv_b_w, conv_b_bias, conv_b_ln_g, conv_b_ln_b,
              gmlp_vn_g, gmlp_vn_b, gmlp_w_s, gmlp_b_s, conv_d_w,
              w_br_a, w_br_b, w_br_c, w_br_d, w_o,
              ffn2_norm_pre, ffn2_norm_post, ffn2_w_gu, ffn2_w_down):
    s = x_prompt.shape[1]
    t = x_sample.shape[1]
    past = cache_kv_latent.shape[2]
    cos_p, sin_p = rope_tables(jnp.arange(s))
    cos_s, sin_s = rope_tables(past + jnp.arange(t))
    xp, xs = x_prompt, x_sample
    zb = jnp.zeros((xp.shape[0], CONV_B_WIDTH - 1, C_B), xp.dtype)
    zd = jnp.zeros((xp.shape[0], CONV_D_WIDTH - 1, C_D), xp.dtype)
    lat_p, kr_p, cb_p, cd_p = [], [], [], []
    lat_s, kr_s, cb_s, vc_s, cd_s = [], [], [], [], []
    for l in range(DEPTH):
        p = {'w_in': w_in[l], 'q_norm': q_norm[l], 'w_uq': w_uq[l], 'kv_norm': kv_norm[l],
             'w_ukv': w_ukv[l], 'conv_b_w': conv_b_w[l], 'conv_b_bias': conv_b_bias[l],
             'conv_b_ln_g': conv_b_ln_g[l], 'conv_b_ln_b': conv_b_ln_b[l],
             'gmlp_vn_g': gmlp_vn_g[l], 'gmlp_vn_b': gmlp_vn_b[l], 'gmlp_w_s': gmlp_w_s[l],
             'gmlp_b_s': gmlp_b_s[l], 'conv_d_w': conv_d_w[l], 'w_br_a': w_br_a[l],
             'w_br_b': w_br_b[l], 'w_br_c': w_br_c[l], 'w_br_d': w_br_d[l], 'w_o': w_o[l]}
        xp = xp + 0.5 * swiglu_ffn(xp, ffn1_norm_pre[l], ffn1_norm_post[l], ffn1_w_gu[l], ffn1_w_down[l])
        xs = xs + 0.5 * swiglu_ffn(xs, ffn1_norm_pre[l], ffn1_norm_post[l], ffn1_w_gu[l], ffn1_w_down[l])
        hp, (a1, a2, a3, _, a5) = token_mixer(rmsnorm(xp, mix_norm_pre[l]), cos_p, sin_p, p,
                                              None, None, zb, zd)
        xp = xp + rmsnorm(hp, mix_norm_post[l])
        hs, (b1, b2, b3, b4, b5) = token_mixer(rmsnorm(xs, mix_norm_pre[l]), cos_s, sin_s, p,
                                               cache_kv_latent[l], cache_k_rope[l],
                                               state_conv_b[l], state_conv_d[l])
        xs = xs + rmsnorm(hs, mix_norm_post[l])
        xp = xp + 0.5 * swiglu_ffn(xp, ffn2_norm_pre[l], ffn2_norm_post[l], ffn2_w_gu[l], ffn2_w_down[l])
        xs = xs + 0.5 * swiglu_ffn(xs, ffn2_norm_pre[l], ffn2_norm_post[l], ffn2_w_gu[l], ffn2_w_down[l])
        lat_p.append(a1); kr_p.append(a2); cb_p.append(a3); cd_p.append(a5)
        lat_s.append(b1); kr_s.append(b2); cb_s.append(b3); vc_s.append(b4); cd_s.append(b5)
    return (xp, xs,
            jnp.stack(lat_p), jnp.stack(kr_p), jnp.stack(cb_p), jnp.stack(cd_p),
            jnp.stack(lat_s), jnp.stack(kr_s), jnp.stack(cb_s), jnp.stack(vc_s), jnp.stack(cd_s))
```

```cpp
#include <hip/hip_runtime.h>
#include <hip/hip_cooperative_groups.h>
#include <cstdio>
namespace cg = cooperative_groups;

#ifndef COOP
#define COOP 1
#endif
#ifndef PMASK
#define PMASK 0xffffffffu
#endif
#define PM(k) ((PMASK >> (k)) & 1u)

typedef unsigned short u16;
using bf16x8 = __attribute__((ext_vector_type(8))) short;
using f32x4 = __attribute__((ext_vector_type(4))) float;
using f32x2 = __attribute__((ext_vector_type(2))) float;
using u32x4 = __attribute__((ext_vector_type(4))) unsigned;
using u32x2 = __attribute__((ext_vector_type(2))) unsigned;

#define EPSV 1e-6f
#define MFMA16(a, b, c) __builtin_amdgcn_mfma_f32_16x16x32_bf16((a), (b), (c), 0, 0, 0)

struct Params {
  const float* in[35];
  float* out;
  char* ws;
};

constexpr int MROWS = 16512;
constexpr int MPR = 16384;
constexpr int HLD = 6656;
constexpr int DIN = 6560;
constexpr int DFF = 2816;
constexpr int C_CQ = 0, C_KV = 384, C_KR = 640, C_GA = 672, C_GG = 928, C_U = 1184, C_V = 1440, C_BG = 1696,
              C_CG = 1952, C_HD = 2208, C_GATE = 2464;
constexpr int KVROWS = 32896;
constexpr int SKEYS = 2064;
constexpr int VSTR_S = 2112;

constexpr size_t O_YP = 0;
constexpr size_t O_YS = O_YP + 16777216;
constexpr size_t O_LATP = O_YS + 131072;
constexpr size_t O_KRP = O_LATP + 16777216;
constexpr size_t O_CBP = O_KRP + 2097152;
constexpr size_t O_CDP = O_CBP + 245760;
constexpr size_t O_LATS = O_CDP + 16384;
constexpr size_t O_KRS = O_LATS + 131072;
constexpr size_t O_CBS = O_KRS + 16384;
constexpr size_t O_VS = O_CBS + 245760;
constexpr size_t O_CDS = O_VS + 131072;

constexpr size_t W_GU1 = 0;
constexpr size_t W_D1 = W_GU1 + (size_t)5632 * 1024 * 2;
constexpr size_t W_IN = W_D1 + (size_t)1024 * 2816 * 2;
constexpr size_t W_UQ = W_IN + (size_t)HLD * 1024 * 2;
constexpr size_t W_UKV = W_UQ + (size_t)768 * 384 * 2;
constexpr size_t W_BRA = W_UKV + (size_t)1024 * 256 * 2;
constexpr size_t W_BRB = W_BRA + (size_t)1024 * 512 * 2;
constexpr size_t W_BRC = W_BRB + (size_t)1024 * 256 * 2;
constexpr size_t W_BRD = W_BRC + (size_t)1024 * 256 * 2;
constexpr size_t W_O = W_BRD + (size_t)1024 * 256 * 2;
constexpr size_t W_GU2 = W_O + (size_t)1024 * 1024 * 2;
constexpr size_t W_D2 = W_GU2 + (size_t)5632 * 1024 * 2;
constexpr size_t B_XB = W_D2 + (size_t)1024 * 2816 * 2;
constexpr size_t B_RSX = B_XB + (size_t)MROWS * 1024 * 2;
constexpr size_t B_RSQ = B_RSX + (size_t)MROWS * 4;
constexpr size_t B_ROPE = B_RSQ + (size_t)MROWS * 4;
constexpr size_t B_CNT = B_ROPE + (size_t)2064 * 16 * 8;
constexpr size_t B_BAR = B_CNT + 256;
constexpr size_t B_BIG = B_BAR + 16384;
constexpr size_t B_Y = B_BIG + (size_t)MROWS * HLD * 2;
constexpr size_t B_Q = B_Y;
constexpr size_t B_KN = B_Q + (size_t)MROWS * 768 * 2;
constexpr size_t B_VTP = B_KN + (size_t)KVROWS * 512 * 2;
constexpr size_t B_VTS = B_VTP + (size_t)64 * 64 * 2048 * 2;
constexpr size_t B_LAT = B_VTS + (size_t)64 * 64 * VSTR_S * 2;
constexpr size_t B_KR = B_LAT + (size_t)KVROWS * 256 * 2;
constexpr size_t B_A = B_KR + (size_t)KVROWS * 32 * 2;
constexpr size_t B_YB = B_A + (size_t)MROWS * 512 * 2;
constexpr size_t B_YC = B_YB + (size_t)MROWS * 256 * 2;
constexpr size_t B_YD = B_YC + (size_t)MROWS * 256 * 2;
constexpr size_t B_MG = B_YD + (size_t)MROWS * 256 * 2;
constexpr size_t WS_NEED = B_MG + (size_t)MROWS * 1024 * 2;
static_assert(B_Y + (size_t)MROWS * 1024 * 4 <= B_VTS, "y alias overflow");

__device__ __forceinline__ int otid() { int t = threadIdx.x; asm volatile("" : "+v"(t)); return t; }
__device__ __forceinline__ u16 f2bf(float f) { return __builtin_bit_cast(u16, (__bf16)f); }
__device__ __forceinline__ float bf2f(u16 h) { return __uint_as_float(((unsigned)h) << 16); }
typedef __bf16 hwbf16x2 __attribute__((ext_vector_type(2)));
__device__ __forceinline__ unsigned pk2(float a, float b) {
  f32x2 v = {a, b};
  return __builtin_bit_cast(unsigned, __builtin_convertvector(v, hwbf16x2));
}
__device__ __forceinline__ u32x2 pack4(float a, float b, float c, float d) {
  u32x2 r; r.x = pk2(a, b); r.y = pk2(c, d); return r;
}
__device__ __forceinline__ void unpack4(u32x2 v, float (&f)[4]) {
  f[0] = __uint_as_float(v.x << 16); f[1] = __uint_as_float(v.x & 0xffff0000u);
  f[2] = __uint_as_float(v.y << 16); f[3] = __uint_as_float(v.y & 0xffff0000u);
}
__device__ __forceinline__ float wave_sum(float v) {
#pragma unroll
  for (int o = 32; o > 0; o >>= 1) v += __shfl_xor(v, o, 64);
  return v;
}
__device__ __forceinline__ float sigm(float x) { return __builtin_amdgcn_rcpf(1.f + __expf(-x)); }

#define XB_TMO      128
#define XB_XCNT(j)  (256  + 64 * (j))
#define XB_XSUB(j)  (1280 + 64 * (j))
#define XB_XGEN(j)  (2304 + 64 * (j))
#define XB_TOP      3328
#define XB_TOPGEN   3392
#define XCD_BAR_WORDS 3456
#define XB_SPIN_CAP (1u << 18)
#define LAS __attribute__((address_space(3)))
__device__ __forceinline__ unsigned xb_ld(unsigned* p) { return __hip_atomic_load(p, __ATOMIC_RELAXED, __HIP_MEMORY_SCOPE_AGENT); }
__device__ __forceinline__ unsigned xb_add(unsigned* p, unsigned v) { return __hip_atomic_fetch_add(p, v, __ATOMIC_RELAXED, __HIP_MEMORY_SCOPE_AGENT); }
__device__ __forceinline__ unsigned xb_xcc_id() { return (unsigned)__builtin_amdgcn_s_getreg((3 << 11) | 20) & 0xFu; }
#define XB_SPIN(cond, bar) do { unsigned _sp = 0; while (cond) { __builtin_amdgcn_s_sleep(1); \
    if ((++_sp & 255u) == 0u) { if (xb_ld(&(bar)[XB_TMO])) break; if (_sp > XB_SPIN_CAP) { atomicAdd(&(bar)[XB_TMO], 1u); break; } } } } while (0)
struct XcdBarrier { unsigned* bar; unsigned x; volatile LAS unsigned* st; };
__device__ __forceinline__ XcdBarrier xcd_barrier_post(unsigned* bar, volatile LAS unsigned* st) {
  XcdBarrier b; b.bar = bar; b.x = xb_xcc_id(); b.st = st;
  if (threadIdx.x == 0) (void)xb_add(&bar[XB_XCNT(b.x)], 1u);
  return b;
}
__device__ __forceinline__ void xcd_barrier_complete(unsigned* bar, unsigned x, unsigned& nloc, unsigned& nx) {
  const unsigned G = gridDim.x * gridDim.y * gridDim.z;
  unsigned sum, cnt, mine, sp = 0u;
  for (;;) {
    sum = 0u; cnt = 0u; mine = 0u;
#pragma unroll
    for (unsigned j = 0; j < 16; ++j) { const unsigned c = xb_ld(&bar[XB_XCNT(j)]); sum += c; cnt += (c > 0u) ? 1u : 0u; mine = (j == x) ? c : mine; }
    if (sum == G) break;
    __builtin_amdgcn_s_sleep(1);
    if ((++sp & 255u) == 0u) { if (xb_ld(&bar[XB_TMO])) break; if (sp > XB_SPIN_CAP) { atomicAdd(&bar[XB_TMO], 1u); break; } }
  }
  nloc = mine > 0u ? mine : 1u; nx = cnt > 0u ? cnt : 1u;
}
__device__ __forceinline__ void xcd_barrier(const XcdBarrier& b) {
  asm volatile("s_waitcnt vmcnt(0)" ::: "memory");
  __syncthreads();
  if (threadIdx.x == 0) {
    unsigned* bar = b.bar;
    __builtin_amdgcn_s_waitcnt(0);
    unsigned nloc = b.st[0], nx = b.st[1];
    if (nloc == 0u) { xcd_barrier_complete(bar, b.x, nloc, nx); b.st[0] = nloc; b.st[1] = nx; }
    const unsigned old = xb_add(&bar[XB_XSUB(b.x)], 1u);
    const unsigned gen = old / nloc;
    if (old + 1u == (gen + 1u) * nloc) {
      __builtin_amdgcn_fence(__ATOMIC_RELEASE, "agent");
      asm volatile("s_waitcnt vmcnt(0)" ::: "memory");
      const unsigned og = xb_add(&bar[XB_TOP], 1u);
      const unsigned tg = og / nx;
      if (og + 1u == (tg + 1u) * nx) xb_add(&bar[XB_TOPGEN], 1u);
      else XB_SPIN(xb_ld(&bar[XB_TOPGEN]) == tg, bar);
      __builtin_amdgcn_fence(__ATOMIC_ACQUIRE, "agent");
      xb_add(&bar[XB_XGEN(b.x)], 1u);
      asm volatile("s_waitcnt vmcnt(0)" ::: "memory");
    } else {
      XB_SPIN(xb_ld(&bar[XB_XGEN(b.x)]) == gen, bar);
      __builtin_amdgcn_fence(__ATOMIC_ACQUIRE, "agent");
      asm volatile("s_waitcnt vmcnt(0)" ::: "memory");
    }
  }
  __syncthreads();
}

#define DSR(dst, addr, OFF) asm volatile("ds_read_b128 %0, %1 offset:" #OFF : "=v"(dst) : "v"(addr))
__device__ __forceinline__ unsigned lds_addr(const char* p) { return (unsigned)(size_t)(LAS const char*)p; }

__device__ __forceinline__ int lds_off(int r, int c) {
  int st = (r >> 4) * 2 + (c >> 5), rr = r & 15, cc = c & 31, ob = rr * 64 + cc * 2;
  return st * 1024 + (ob ^ (((ob >> 9) & 1) << 5));
}

template <int NN>
__device__ __forceinline__ void gemm_first(const u16* __restrict__ A, int lda, const u16* __restrict__ Bt, int ldb,
                                           int row0, int col0, char* smem) {
  const int tid = otid(), lane = tid & 63, wid = tid >> 6;
  const int l2 = lane ^ ((lane >> 5) << 1);
  const int Rl = (wid >> 1) * 16 + (l2 >> 2), Cl = (wid & 1) * 32 + (l2 & 3) * 8;
  const u16* ag = A + (size_t)(row0 + Rl) * lda + Cl;
  const u16* bg = Bt + (size_t)(col0 + Rl) * ldb + Cl;
  const size_t astep = (size_t)32 * lda, bstep = (size_t)32 * ldb;
  char* dA = smem + tid * 16;
  char* dB = smem + 32768 + tid * 16;
#pragma unroll
  for (int i = 0; i < 4; ++i)
    __builtin_amdgcn_global_load_lds((const unsigned*)(ag + i * astep), (LAS unsigned*)(dA + i * 4096), 16, 0, 0);
#pragma unroll
  for (int i = 0; i < NN; ++i)
    __builtin_amdgcn_global_load_lds((const unsigned*)(bg + i * bstep), (LAS unsigned*)(dB + i * 4096), 16, 0, 0);
}

template <int NN>
__device__ __forceinline__ void gemm_main(const u16* __restrict__ A, int lda, const u16* __restrict__ Bt, int ldb,
                                          int K, int row0, int col0, f32x4 (&acc)[4][NN], char* smem,
                                          bool pre = false) {
  const int tid = otid(), lane = tid & 63, wid = tid >> 6, wr = wid >> 1, wc = wid & 1;
  const int fr = lane & 15, fq = lane >> 4;
  const int l2 = lane ^ ((lane >> 5) << 1);
  const int Rl = (wid >> 1) * 16 + (l2 >> 2), Cl = (wid & 1) * 32 + (l2 & 3) * 8;
  const u16* ag = A + (size_t)(row0 + Rl) * lda + Cl;
  const u16* bg = Bt + (size_t)(col0 + Rl) * ldb + Cl;
  const size_t astep = (size_t)32 * lda, bstep = (size_t)32 * ldb;
  const int rbase = (fr * 64 + fq * 16) ^ (((fr >> 3) & 1) << 5);
  char* sA = smem;
  char* sB = smem + 32768;
  char* dA = sA + tid * 16;
  char* dB = sB + tid * 16;
#define GLDS(gp, lp) __builtin_amdgcn_global_load_lds((const unsigned*)(gp), (LAS unsigned*)(lp), 16, 0, 0)
  if (!pre) {
    __syncthreads();
#pragma unroll
    for (int i = 0; i < 4; ++i) GLDS(ag + i * astep, dA + i * 4096);
#pragma unroll
    for (int i = 0; i < NN; ++i) GLDS(bg + i * bstep, dB + i * 4096);
  }
  asm volatile("s_waitcnt vmcnt(0)" ::: "memory");
  __syncthreads();
  const int nk = K >> 6;
  for (int kt = 0; kt < nk; ++kt) {
    const int cur = kt & 1;
    if (kt + 1 < nk) {
      const int ko = (kt + 1) * 64;
      char* na = dA + (cur ^ 1) * 16384;
      char* nb = dB + (cur ^ 1) * 16384;
#pragma unroll
      for (int i = 0; i < 4; ++i) GLDS(ag + i * astep + ko, na + i * 4096);
#pragma unroll
      for (int i = 0; i < NN; ++i) GLDS(bg + i * bstep + ko, nb + i * 4096);
    }
    const char* a_s = sA + cur * 16384 + rbase + wr * 8192;
    const char* b_s = sB + cur * 16384 + rbase + wc * (NN * 2048);
    {
      const unsigned aaddr = lds_addr(a_s), baddr = lds_addr(b_s);
      bf16x8 af[2][4], bfv[2][NN];
      DSR(af[0][0], aaddr, 0); DSR(af[0][1], aaddr, 2048); DSR(af[0][2], aaddr, 4096); DSR(af[0][3], aaddr, 6144);
      DSR(bfv[0][0], baddr, 0); DSR(bfv[0][1], baddr, 2048);
      if (NN == 4) { DSR(bfv[0][NN - 2], baddr, 4096); DSR(bfv[0][NN - 1], baddr, 6144); }
      DSR(af[1][0], aaddr, 1024); DSR(af[1][1], aaddr, 3072); DSR(af[1][2], aaddr, 5120); DSR(af[1][3], aaddr, 7168);
      DSR(bfv[1][0], baddr, 1024); DSR(bfv[1][1], baddr, 3072);
      if (NN == 4) { DSR(bfv[1][NN - 2], baddr, 5120); DSR(bfv[1][NN - 1], baddr, 7168); }
      if (NN == 4) {
        asm volatile("s_waitcnt lgkmcnt(8)"
                     : "+v"(af[0][0]), "+v"(af[0][1]), "+v"(af[0][2]), "+v"(af[0][3]), "+v"(bfv[0][0]),
                       "+v"(bfv[0][1]), "+v"(bfv[0][NN - 2]), "+v"(bfv[0][NN - 1]));
      } else {
        asm volatile("s_waitcnt lgkmcnt(6)"
                     : "+v"(af[0][0]), "+v"(af[0][1]), "+v"(af[0][2]), "+v"(af[0][3]), "+v"(bfv[0][0]),
                       "+v"(bfv[0][1]));
      }
#pragma unroll
      for (int m = 0; m < 4; ++m)
#pragma unroll
        for (int n = 0; n < NN; ++n) acc[m][n] = MFMA16(af[0][m], bfv[0][n], acc[m][n]);
      if (NN == 4) {
        asm volatile("s_waitcnt lgkmcnt(0)"
                     : "+v"(af[1][0]), "+v"(af[1][1]), "+v"(af[1][2]), "+v"(af[1][3]), "+v"(bfv[1][0]),
                       "+v"(bfv[1][1]), "+v"(bfv[1][NN - 2]), "+v"(bfv[1][NN - 1]));
      } else {
        asm volatile("s_waitcnt lgkmcnt(0)"
                     : "+v"(af[1][0]), "+v"(af[1][1]), "+v"(af[1][2]), "+v"(af[1][3]), "+v"(bfv[1][0]),
                       "+v"(bfv[1][1]));
      }
#pragma unroll
      for (int m = 0; m < 4; ++m)
#pragma unroll
        for (int n = 0; n < NN; ++n) acc[m][n] = MFMA16(af[1][m], bfv[1][n], acc[m][n]);
      __builtin_amdgcn_sched_barrier(0);
    }
    asm volatile("s_waitcnt vmcnt(0)" ::: "memory");
    __syncthreads();
  }
#undef GLDS
}

#define ZERO_ACC(acc)                                  \
  _Pragma("unroll") for (int m_ = 0; m_ < 4; ++m_)     \
  _Pragma("unroll") for (int n_ = 0; n_ < 4; ++n_) acc[m_][n_] = f32x4{0.f, 0.f, 0.f, 0.f};

#define TILE_IDS                                                            \
  const int tid = otid(), lane = tid & 63, wid = tid >> 6;             \
  const int wr = wid >> 1, wc = wid & 1, fr = lane & 15, fq = lane >> 4;    \
  (void)tid; (void)lane; (void)wid; (void)wr; (void)wc; (void)fr; (void)fq;

__device__ void ffn_up_tile(const u16* xb, const u16* Wt, const float* rsx, u16* Hff, int mt, int nt, char* smem) {
  TILE_IDS
  f32x4 acc[4][4];
  ZERO_ACC(acc)
  gemm_main<4>(xb, 1024, Wt, 1024, 1024, mt * 128, nt * 128, acc, smem);
#pragma unroll
  for (int m = 0; m < 4; ++m)
#pragma unroll
    for (int j = 0; j < 4; ++j) {
      const int row = mt * 128 + wr * 64 + m * 16 + fq * 4 + j;
      const float r = rsx[row];
#pragma unroll
      for (int n = 0; n < 2; ++n) {
        const float g = acc[m][n][j] * r, u = acc[m][n + 2][j] * r;
        const float v = g * sigm(g) * u;
        Hff[(size_t)row * DFF + nt * 64 + wc * 32 + n * 16 + fr] = f2bf(v);
      }
    }
}

__device__ __forceinline__ bool tile_map(int i, int MT, int NT, int& mt, int& nt) {
  const int T = MT * NT, chunk = (T + 7) >> 3;
  const int x = i & 7, q = i >> 3;
  if (q >= chunk) return false;
  const int t = x * chunk + q;
  if (t >= T) return false;
  const int full = NT >> 3, pb = MT * 8;
  const int np = t / pb;
  if (np < full) { const int rem = t - np * pb; mt = rem >> 3; nt = np * 8 + (rem & 7); }
  else { const int wl = NT & 7; const int rem = t - full * pb; mt = rem / wl; nt = full * 8 + rem % wl; }
  return true;
}
#define FOR_TILES(MT, NT) \
  for (int i_ = bid, mt, nt; i_ < 8 * (((MT) * (NT) + 7) >> 3); i_ += nb) if (tile_map(i_, (MT), (NT), mt, nt))

#define GLDS(gp, lp) __builtin_amdgcn_global_load_lds((const unsigned*)(gp), (LAS unsigned*)(lp), 16, 0, 0)
__device__ __forceinline__ void big_issue(const u16* ag, const u16* bg, size_t astep, size_t bstep, char* dst) {
#pragma unroll
  for (int i = 0; i < 2; ++i) GLDS(ag + i * astep, dst + i * 4096);
#pragma unroll
  for (int i = 0; i < 4; ++i) GLDS(bg + i * bstep, dst + 8192 + i * 4096);
}
#undef GLDS

__device__ __forceinline__ bool next_tile(int& i, int nb, int bound, int MT, int NT, int& mt, int& nt) {
  while (i < bound) {
    if (tile_map(i, MT, NT, mt, nt)) return true;
    i += nb;
  }
  return false;
}

template <class Epi>
__device__ __forceinline__ void big_gemm_phase(const u16* __restrict__ A, int lda, const u16* __restrict__ Bt, int ldb,
                                               int K, int MT, int NT, char* smem, const float* __restrict__ rowscale, Epi epi) {
  const int tid = otid(), lane = tid & 63, wid = tid >> 6, wr = wid >> 1, wc = wid & 1;
  const int fr = lane & 15, fq = lane >> 4;
  const int l2 = lane ^ ((lane >> 5) << 1);
  const int Rl = wid * 16 + (l2 >> 2), Cl = (l2 & 3) * 8;
  const size_t astep = (size_t)64 * lda, bstep = (size_t)64 * ldb;
  const int rbase = (fr * 64 + fq * 16) ^ (((fr >> 3) & 1) << 5);
  const unsigned sbase = lds_addr(smem);
  const unsigned aoff = rbase + wr * 4096, boff = 8192 + rbase + wc * 8192;
  char* dst = smem + tid * 16;
  const int nb = gridDim.x, bound = 8 * ((MT * NT + 7) >> 3), nk = K >> 5;
  int i = blockIdx.x, mt, nt;
  bool have = next_tile(i, nb, bound, MT, NT, mt, nt);
  if (!have) return;
  const u16* ag = A + (size_t)(mt * 128 + Rl) * lda + Cl;
  const u16* bg = Bt + (size_t)(nt * 256 + Rl) * ldb + Cl;
  __syncthreads();
  big_issue(ag, bg, astep, bstep, dst);
  while (have) {
    f32x4 acc[4][8];
#pragma unroll
    for (int m = 0; m < 4; ++m)
#pragma unroll
      for (int n = 0; n < 8; ++n) acc[m][n] = f32x4{0.f, 0.f, 0.f, 0.f};
    float rs[4];
#pragma unroll
    for (int m = 0; m < 4; ++m) rs[m] = rowscale[mt * 128 + wr * 64 + m * 16 + fr];
    asm volatile("s_waitcnt vmcnt(0)" ::: "memory");
    __syncthreads();
    for (int kt = 0; kt < nk; ++kt) {
      const int cur = kt & 1;
      if (kt + 1 < nk) big_issue(ag + (kt + 1) * 32, bg + (kt + 1) * 32, astep, bstep, dst + (cur ^ 1) * 24576);
      bf16x8 af[4], bfv[8];
      {
        const unsigned aaddr = sbase + cur * 24576 + aoff, baddr = sbase + cur * 24576 + boff;
        DSR(af[0], aaddr, 0); DSR(af[1], aaddr, 1024); DSR(af[2], aaddr, 2048); DSR(af[3], aaddr, 3072);
        DSR(bfv[0], baddr, 0); DSR(bfv[1], baddr, 1024); DSR(bfv[2], baddr, 2048); DSR(bfv[3], baddr, 3072);
        DSR(bfv[4], baddr, 4096); DSR(bfv[5], baddr, 5120); DSR(bfv[6], baddr, 6144); DSR(bfv[7], baddr, 7168);
        asm volatile("s_waitcnt lgkmcnt(0)"
                     : "+v"(af[0]), "+v"(af[1]), "+v"(af[2]), "+v"(af[3]), "+v"(bfv[0]), "+v"(bfv[1]), "+v"(bfv[2]),
                       "+v"(bfv[3]), "+v"(bfv[4]), "+v"(bfv[5]), "+v"(bfv[6]), "+v"(bfv[7]));
      }
#pragma unroll
      for (int m = 0; m < 4; ++m)
#pragma unroll
        for (int n = 0; n < 8; ++n) acc[m][n] = MFMA16(bfv[n], af[m], acc[m][n]);
      __builtin_amdgcn_sched_barrier(0);
      asm volatile("s_waitcnt vmcnt(0)" ::: "memory");
      __syncthreads();
    }
    const int cmt = mt, cnt = nt;
    i += nb;
    have = next_tile(i, nb, bound, MT, NT, mt, nt);
    if (have) {
      ag = A + (size_t)(mt * 128 + Rl) * lda + Cl;
      bg = Bt + (size_t)(nt * 256 + Rl) * ldb + Cl;
      big_issue(ag, bg, astep, bstep, dst);
    }
    epi(acc, rs, cmt, cnt, wr, wc, fr, fq, smem + 24576);
  }
}

#define ZERO_ACC8(acc)                                 \
  _Pragma("unroll") for (int m_ = 0; m_ < 4; ++m_)     \
  _Pragma("unroll") for (int n_ = 0; n_ < 8; ++n_) acc[m_][n_] = f32x4{0.f, 0.f, 0.f, 0.f};

__device__ void ffn_up_phase(const u16* xb, const u16* Wt, const float* rsx, u16* Hff, char* smem) {
  big_gemm_phase(xb, 1024, Wt, 1024, 1024, 129, 22, smem, rsx,
                 [&](f32x4 (&acc)[4][8], const float (&rs)[4], int mt, int nt, int wr, int wc, int fr, int fq, char* stg) {
#pragma unroll
                   for (int m = 0; m < 4; ++m) {
                     const int lr = wr * 64 + m * 16 + fr;
                     const float r = rs[m];
                     char* sp = stg + lr * 272 + (wc * 64 + fq * 4) * 2;
#pragma unroll
                     for (int n = 0; n < 4; ++n) {
                       float v[4];
#pragma unroll
                       for (int jj = 0; jj < 4; ++jj) {
                         const float g = acc[m][n][jj] * r, u = acc[m][n + 4][jj] * r;
                         v[jj] = g * sigm(g) * u;
                       }
                       *(u32x2*)(sp + n * 32) = pack4(v[0], v[1], v[2], v[3]);
                     }
                   }
                   __syncthreads();
                   const int tid = otid();
#pragma unroll
                   for (int it = 0; it < 8; ++it) {
                     const int ch = tid + 256 * it, lr = ch >> 4, c16 = ch & 15;
                     const u32x4 v = *(const u32x4*)(stg + lr * 272 + c16 * 16);
                     *(u32x4*)(Hff + (size_t)(mt * 128 + lr) * DFF + nt * 128 + c16 * 8) = v;
                   }
                 });
}

__device__ void win_phase(const u16* xb, const u16* Wt, const float* rsx, u16* h, char* smem) {
  big_gemm_phase(xb, 1024, Wt, 1024, 1024, 129, 26, smem, rsx,
                 [&](f32x4 (&acc)[4][8], const float (&rs)[4], int mt, int nt, int wr, int wc, int fr, int fq, char* stg) {
                   const int tid = otid();
#pragma unroll
                   for (int ps = 0; ps < 2; ++ps) {
                     if (ps) __syncthreads();
#pragma unroll
                     for (int m = 0; m < 4; ++m) {
                       const int lr = wr * 64 + m * 16 + fr;
                       const float r = rs[m];
                       char* sp = stg + lr * 272 + (wc * 64 + fq * 4) * 2;
#pragma unroll
                       for (int n = 0; n < 4; ++n) {
                         const int cb = nt * 256 + wc * 128 + (ps * 4 + n) * 16;
                         float v[4];
#pragma unroll
                         for (int jj = 0; jj < 4; ++jj) {
                           v[jj] = acc[m][ps * 4 + n][jj] * r;
                           if (cb >= C_GATE) v[jj] = sigm(v[jj]);
                         }
                         *(u32x2*)(sp + n * 32) = pack4(v[0], v[1], v[2], v[3]);
                       }
                     }
                     __syncthreads();
#pragma unroll
                     for (int it = 0; it < 8; ++it) {
                       const int ch = tid + 256 * it, lr = ch >> 4, c16 = ch & 15;
                       const u32x4 v = *(const u32x4*)(stg + lr * 272 + c16 * 16);
                       const int c = c16 * 8;
                       *(u32x4*)(h + (size_t)(mt * 128 + lr) * HLD + nt * 256 + (c >> 6) * 128 + ps * 64 + (c & 63)) = v;
                     }
                   }
                 });
}

struct F32Item { int mt, nt, k0, kc; bool atomic; };
__device__ __forceinline__ bool f32_item(int i, int KS, int K, F32Item& it) {
  const int bound = 1024;
  if (i >= bound + 8 * KS) return false;
  if (i < bound) {
    tile_map(i, 128, 8, it.mt, it.nt);
    it.k0 = 0; it.kc = K; it.atomic = false;
  } else {
    const int u = i - bound, kcs = K / KS;
    it.mt = 128; it.nt = u & 7; it.k0 = (u >> 3) * kcs; it.kc = kcs; it.atomic = true;
  }
  return true;
}
__device__ void gemm_f32_phase(const u16* A, int lda, int K, const u16* Wt, float* y, int KS, char* smem) {
  TILE_IDS
  const int nb = gridDim.x;
  int i = blockIdx.x;
  F32Item cur, nxt;
  bool have = f32_item(i, KS, K, cur);
  if (!have) return;
  __syncthreads();
  gemm_first<4>(A + cur.k0, lda, Wt + cur.k0, K, cur.mt * 128, cur.nt * 128, smem);
  while (have) {
    f32x4 acc[4][4];
    ZERO_ACC(acc)
    gemm_main<4>(A + cur.k0, lda, Wt + cur.k0, K, cur.kc, cur.mt * 128, cur.nt * 128, acc, smem, true);
    i += nb;
    const bool hn = f32_item(i, KS, K, nxt);
    if (hn) gemm_first<4>(A + nxt.k0, lda, Wt + nxt.k0, K, nxt.mt * 128, nxt.nt * 128, smem);
#pragma unroll
    for (int m = 0; m < 4; ++m)
#pragma unroll
      for (int j = 0; j < 4; ++j) {
        const int row = cur.mt * 128 + wr * 64 + m * 16 + fq * 4 + j;
        float* yp = y + (size_t)row * 1024 + cur.nt * 128 + wc * 64 + fr;
        if (cur.atomic) {
#pragma unroll
          for (int n = 0; n < 4; ++n)
            (void)__hip_atomic_fetch_add(yp + n * 16, acc[m][n][j], __ATOMIC_RELAXED, __HIP_MEMORY_SCOPE_AGENT);
        } else {
#pragma unroll
          for (int n = 0; n < 4; ++n) yp[n * 16] = acc[m][n][j];
        }
      }
    cur = nxt;
    have = hn;
  }
}

__device__ void zero_y_sample(float* y) {
  for (int i = blockIdx.x * 256 + otid(); i < 128 * 1024; i += gridDim.x * 256) y[(size_t)MPR * 1024 + i] = 0.f;
}

__device__ void win_tile(const u16* xb, const u16* Wt, const float* rsx, u16* h, int mt, int nt, char* smem) {
  TILE_IDS
  f32x4 acc[4][4];
  ZERO_ACC(acc)
  gemm_main<4>(xb, 1024, Wt, 1024, 1024, mt * 128, nt * 128, acc, smem);
#pragma unroll
  for (int m = 0; m < 4; ++m)
#pragma unroll
    for (int j = 0; j < 4; ++j) {
      const int row = mt * 128 + wr * 64 + m * 16 + fq * 4 + j;
      const float r = rsx[row];
#pragma unroll
      for (int n = 0; n < 4; ++n) {
        const int cb = nt * 128 + wc * 64 + n * 16;
        float v = acc[m][n][j] * r;
        if (cb >= C_GATE) v = sigm(v);
        h[(size_t)row * HLD + cb + fr] = f2bf(v);
      }
    }
}

__device__ void q_tile(const u16* h, const u16* Wt, const float* rsq, const f32x2* ropeT, u16* q, int mt, int nt,
                       char* smem) {
  TILE_IDS
  f32x4 acc[4][4];
  ZERO_ACC(acc)
  gemm_main<4>(h + C_CQ, HLD, Wt, 384, 384, mt * 128, nt * 128, acc, smem);
  const float QS = 0.10206207261596577f * 1.4426950408889634f;
  const int s0 = (nt * 128 + wc * 64) >> 4;
#pragma unroll
  for (int m = 0; m < 4; ++m)
#pragma unroll
    for (int j = 0; j < 4; ++j) {
      const int row = mt * 128 + wr * 64 + m * 16 + fq * 4 + j;
      const float r = rsq[row] * QS;
      float v[4];
#pragma unroll
      for (int n = 0; n < 4; ++n) v[n] = acc[m][n][j] * r;
      const int pos = row < MPR ? (row & 2047) : 2048 + ((row - MPR) & 15);
      const f32x2 cs = ropeT[pos * 16 + fr];
#pragma unroll
      for (int n = 0; n < 4; n += 2) {
        if (((s0 + n) % 6) == 4) {
          const float x1 = v[n], x2 = v[n + 1];
          v[n] = x1 * cs.x - x2 * cs.y;
          v[n + 1] = x2 * cs.x + x1 * cs.y;
        }
      }
#pragma unroll
      for (int n = 0; n < 4; ++n) q[(size_t)row * 768 + nt * 128 + wc * 64 + n * 16 + fr] = f2bf(v[n]);
    }
}

__device__ void kv_tile(const u16* lat, const u16* Wt, u16* Kn, u16* Vtp, u16* Vts, int mt, int nt, char* smem) {
  TILE_IDS
  f32x4 acc[4][4];
  ZERO_ACC(acc)
  gemm_main<4>(lat, 256, Wt, 256, 256, mt * 128, nt * 128, acc, smem);
  const int hh = nt;
  if (wc == 0) {
#pragma unroll
    for (int m = 0; m < 4; ++m)
#pragma unroll
      for (int j = 0; j < 4; ++j) {
        const int row = mt * 128 + wr * 64 + m * 16 + fq * 4 + j;
#pragma unroll
        for (int n = 0; n < 4; ++n) Kn[(size_t)row * 512 + hh * 64 + n * 16 + fr] = f2bf(acc[m][n][j]);
      }
  } else {
#pragma unroll
    for (int m = 0; m < 4; ++m) {
      const int row = mt * 128 + wr * 64 + m * 16 + fq * 4;
      u16* base;
      size_t stride;
      int key;
      if (row < MPR) {
        const int b = row >> 11;
        key = row & 2047;
        base = Vtp + (size_t)(b * 8 + hh) * 64 * 2048;
        stride = 2048;
      } else {
        const int r2 = row - MPR;
        const int b = r2 / SKEYS;
        key = r2 - b * SKEYS;
        base = Vts + (size_t)(b * 8 + hh) * 64 * VSTR_S;
        stride = VSTR_S;
      }
#pragma unroll
      for (int n = 0; n < 4; ++n) {
        const int dim = n * 16 + fr;
        *(u32x2*)(base + (size_t)dim * stride + key) = pack4(acc[m][n][0], acc[m][n][1], acc[m][n][2], acc[m][n][3]);
      }
    }
  }
}

__device__ void merge_tile(const u16* abuf, const u16* yb, const u16* yc, const u16* yd, const u16* wa, const u16* wb,
                           const u16* wcc, const u16* wd, const u16* h, u16* mg, int mt, int nt, bool pre, bool hn, int mt2,
                           int nt2, char* smem) {
  TILE_IDS
  f32x4 tot[4][2];
#pragma unroll
  for (int m = 0; m < 4; ++m)
#pragma unroll
    for (int n = 0; n < 2; ++n) tot[m][n] = f32x4{0.f, 0.f, 0.f, 0.f};
  for (int b = 0; b < 4; ++b) {
    f32x4 acc[4][2];
#pragma unroll
    for (int m = 0; m < 4; ++m)
#pragma unroll
      for (int n = 0; n < 2; ++n) acc[m][n] = f32x4{0.f, 0.f, 0.f, 0.f};
    const u16* A = b == 0 ? abuf : (b == 1 ? yb : (b == 2 ? yc : yd));
    const u16* W = b == 0 ? wa : (b == 1 ? wb : (b == 2 ? wcc : wd));
    const int K = b == 0 ? 512 : 256;
    if (b == 0 && !pre) { __syncthreads(); gemm_first<2>(A, K, W, K, mt * 128, nt * 64, smem); }
    u16 gv[4][4][2];
#pragma unroll
    for (int m = 0; m < 4; ++m)
#pragma unroll
      for (int j = 0; j < 4; ++j) {
        const int row = mt * 128 + wr * 64 + m * 16 + fq * 4 + j;
        const u16* gp = h + (size_t)row * HLD + C_GATE + b * 1024 + nt * 64 + wc * 32 + fr;
        gv[m][j][0] = gp[0]; gv[m][j][1] = gp[16];
      }
    gemm_main<2>(A, K, W, K, K, mt * 128, nt * 64, acc, smem, true);
    if (b < 3) {
      const u16* A2 = b == 0 ? yb : (b == 1 ? yc : yd);
      const u16* W2 = b == 0 ? wb : (b == 1 ? wcc : wd);
      gemm_first<2>(A2, 256, W2, 256, mt * 128, nt * 64, smem);
    }
#pragma unroll
    for (int m = 0; m < 4; ++m)
#pragma unroll
      for (int j = 0; j < 4; ++j) {
#pragma unroll
        for (int n = 0; n < 2; ++n) tot[m][n][j] += bf2f(gv[m][j][n]) * acc[m][n][j];
      }
  }
  if (hn) gemm_first<2>(abuf, 512, wa, 512, mt2 * 128, nt2 * 64, smem);
#pragma unroll
  for (int m = 0; m < 4; ++m)
#pragma unroll
    for (int j = 0; j < 4; ++j) {
      const int row = mt * 128 + wr * 64 + m * 16 + fq * 4 + j;
#pragma unroll
      for (int n = 0; n < 2; ++n) mg[(size_t)row * 1024 + nt * 64 + wc * 32 + n * 16 + fr] = f2bf(tot[m][n][j]);
    }
}

__device__ __forceinline__ void conv_load(const float* __restrict__ src, int ld, int nvalid, int mode,
                                          const float* __restrict__ scale, int n0, int k0, float (&v)[16]) {
  const int tid = otid();
  const int nn = tid & 63, kk0 = tid >> 6;
  const int n = n0 + nn;
  int sc = n;
  if (mode == 1) {
    const int G = n >> 4, T = G >> 4, w = (G >> 3) & 1, q = G & 7;
    sc = (q >> 2) * DFF + T * 128 + w * 64 + (q & 3) * 16 + (n & 15);
  }
  const bool valid = n < nvalid;
#pragma unroll
  for (int i = 0; i < 16; ++i) {
    const int kk = kk0 + 4 * i;
    float x = 0.f;
    if (valid) {
      x = src[(size_t)(k0 + kk) * ld + sc];
      if (scale) x *= scale[k0 + kk];
    }
    v[i] = x;
  }
}
__device__ __forceinline__ void conv_commit(const float (&v)[16], u16* __restrict__ dst, int K, int n0, int k0,
                                            char* smem) {
  float* sm = (float*)smem;
  const int tid = otid();
  __syncthreads();
  {
    const int nn = tid & 63, kk0 = tid >> 6;
#pragma unroll
    for (int i = 0; i < 16; ++i) sm[(kk0 + 4 * i) * 65 + nn] = v[i];
  }
  __syncthreads();
  {
    const int c8 = tid & 7;
#pragma unroll
    for (int it = 0; it < 2; ++it) {
      const int nn = (tid >> 3) + 32 * it;
      float f[8];
#pragma unroll
      for (int e = 0; e < 8; ++e) f[e] = sm[(c8 * 8 + e) * 65 + nn];
      u32x4 o;
      o.x = pk2(f[0], f[1]); o.y = pk2(f[2], f[3]); o.z = pk2(f[4], f[5]); o.w = pk2(f[6], f[7]);
      *(u32x4*)(dst + (size_t)(n0 + nn) * K + k0 + c8 * 8) = o;
    }
  }
}

__device__ void convert_layer(const Params& p, int l, char* smem) {
  char* ws = p.ws;
  const int NJ = 12;
  const int jt[NJ + 1] = {0, 1408, 2112, 3776, 3848, 3912, 4040, 4104, 4168, 4232, 4488, 5896, 6600};
  bool havePrev = false;
  float pv[16];
  u16* pdst = nullptr;
  int pK = 0, pn0 = 0, pk0 = 0;
  for (int it = blockIdx.x;; it += gridDim.x) {
    const bool valid = it < 6600;
    float nv[16];
    u16* ndst_p = nullptr;
    int nK = 0, nn0 = 0, nk0 = 0;
    if (valid) {
      int j = 0, jbase = 0;
#pragma unroll
      for (int q = 1; q < NJ; ++q)
        if (it >= jt[q]) { j = q; jbase = jt[q]; }
      const int loc = it - jbase;
      const float* src; int ld, K, nvalid, mode = 0, ndst; u16* dst; const float* scale = nullptr;
      switch (j) {
        case 0: src = p.in[8] + (size_t)l * 1024 * 5632; ld = 5632; K = 1024; ndst = 5632; nvalid = 5632; mode = 1;
                dst = (u16*)(ws + W_GU1); scale = p.in[6] + l * 1024; break;
        case 1: src = p.in[9] + (size_t)l * 2816 * 1024; ld = 1024; K = 2816; ndst = 1024; nvalid = 1024;
                dst = (u16*)(ws + W_D1); break;
        case 2: src = p.in[12] + (size_t)l * 1024 * DIN; ld = DIN; K = 1024; ndst = HLD; nvalid = DIN;
                dst = (u16*)(ws + W_IN); scale = p.in[10] + l * 1024; break;
        case 3: src = p.in[14] + (size_t)l * 384 * 768; ld = 768; K = 384; ndst = 768; nvalid = 768;
                dst = (u16*)(ws + W_UQ); scale = p.in[13] + l * 384; break;
        case 4: src = p.in[16] + (size_t)l * 256 * 1024; ld = 1024; K = 256; ndst = 1024; nvalid = 1024;
                dst = (u16*)(ws + W_UKV); break;
        case 5: src = p.in[26] + (size_t)l * 512 * 1024; ld = 1024; K = 512; ndst = 1024; nvalid = 1024;
                dst = (u16*)(ws + W_BRA); break;
        case 6: src = p.in[27] + (size_t)l * 256 * 1024; ld = 1024; K = 256; ndst = 1024; nvalid = 1024;
                dst = (u16*)(ws + W_BRB); break;
        case 7: src = p.in[28] + (size_t)l * 256 * 1024; ld = 1024; K = 256; ndst = 1024; nvalid = 1024;
                dst = (u16*)(ws + W_BRC); break;
        case 8: src = p.in[29] + (size_t)l * 256 * 1024; ld = 1024; K = 256; ndst = 1024; nvalid = 1024;
                dst = (u16*)(ws + W_BRD); break;
        case 9: src = p.in[30] + (size_t)l * 1024 * 1024; ld = 1024; K = 1024; ndst = 1024; nvalid = 1024;
                dst = (u16*)(ws + W_O); break;
        case 10: src = p.in[33] + (size_t)l * 1024 * 5632; ld = 5632; K = 1024; ndst = 5632; nvalid = 5632; mode = 1;
                dst = (u16*)(ws + W_GU2); scale = p.in[31] + l * 1024; break;
        default: src = p.in[34] + (size_t)l * 2816 * 1024; ld = 1024; K = 2816; ndst = 1024; nvalid = 1024;
                dst = (u16*)(ws + W_D2); break;
      }
      const int ntn = ndst >> 6;
      nn0 = (loc % ntn) * 64; nk0 = (loc / ntn) * 64; nK = K; ndst_p = dst;
      conv_load(src, ld, nvalid, mode, scale, nn0, nk0, nv);
    }
    if (havePrev) conv_commit(pv, pdst, pK, pn0, pk0, smem);
    if (!valid) break;
#pragma unroll
    for (int q = 0; q < 16; ++q) pv[q] = nv[q];
    pdst = ndst_p; pK = nK; pn0 = nn0; pk0 = nk0; havePrev = true;
  }
  for (int it = 6600 + blockIdx.x; it < 6600 + 288; it += gridDim.x) {
    {
      const int ci = it - 6600;
      const int tid = otid();
      if (ci < 256) {
        const float* src = p.in[2] + (size_t)l * 8 * 2048 * 256;
        u16* dst = (u16*)(ws + B_LAT) + (size_t)MPR * 256;
#pragma unroll 2
        for (int i = 0; i < 8; ++i) {
          const size_t ch = (size_t)ci * 2048 + i * 256 + tid;
          const size_t e = ch * 8;
          const int b = (int)(e / (2048 * 256));
          const size_t within = e - (size_t)b * 2048 * 256;
          const f32x4 v0 = *(const f32x4*)(src + e), v1 = *(const f32x4*)(src + e + 4);
          u32x4 o;
          o.x = pk2(v0.x, v0.y); o.y = pk2(v0.z, v0.w); o.z = pk2(v1.x, v1.y); o.w = pk2(v1.z, v1.w);
          *(u32x4*)(dst + (size_t)b * SKEYS * 256 + within) = o;
        }
      } else {
        const int c2 = ci - 256;
        const float* src = p.in[3] + (size_t)l * 8 * 2048 * 32;
        u16* dst = (u16*)(ws + B_KR) + (size_t)MPR * 32;
#pragma unroll 2
        for (int i = 0; i < 8; ++i) {
          const size_t ch = (size_t)c2 * 2048 + i * 256 + tid;
          const size_t e = ch * 8;
          const int b = (int)(e / (2048 * 32));
          const size_t within = e - (size_t)b * 2048 * 32;
          const f32x4 v0 = *(const f32x4*)(src + e), v1 = *(const f32x4*)(src + e + 4);
          u32x4 o;
          o.x = pk2(v0.x, v0.y); o.y = pk2(v0.z, v0.w); o.z = pk2(v1.x, v1.y); o.w = pk2(v1.z, v1.w);
          *(u32x4*)(dst + (size_t)b * SKEYS * 32 + within) = o;
        }
      }
    }
  }
}

__device__ void row_update(const Params& p, int mode, float alpha, const float* g) {
  const int lane = otid() & 63, wid = otid() >> 6;
  float* x = p.out;
  const float* y = (const float*)(p.ws + B_Y);
  u16* xb = (u16*)(p.ws + B_XB);
  float* rsx = (float*)(p.ws + B_RSX);
  const int stride = gridDim.x * 4;
  int row = blockIdx.x * 4 + wid;
  if (row >= MROWS) return;
  f32x4 xv[4], yv[4], gv[4];
  if (mode == 0) {
#pragma unroll
    for (int i = 0; i < 4; ++i) { yv[i] = f32x4{0.f, 0.f, 0.f, 0.f}; gv[i] = f32x4{0.f, 0.f, 0.f, 0.f}; }
  } else {
#pragma unroll
    for (int i = 0; i < 4; ++i) gv[i] = *(const f32x4*)(g + i * 256 + lane * 4);
  }
  auto load_row = [&](int r, f32x4 (&xr)[4], f32x4 (&yr)[4]) {
    if (mode == 0) {
      const float* src = r < MPR ? p.in[0] + (size_t)r * 1024 : p.in[1] + (size_t)(r - MPR) * 1024;
#pragma unroll
      for (int i = 0; i < 4; ++i) xr[i] = *(const f32x4*)(src + i * 256 + lane * 4);
    } else {
#pragma unroll
      for (int i = 0; i < 4; ++i) {
        yr[i] = *(const f32x4*)(y + (size_t)r * 1024 + i * 256 + lane * 4);
        xr[i] = *(const f32x4*)(x + (size_t)r * 1024 + i * 256 + lane * 4);
      }
    }
  };
  load_row(row, xv, yv);
  for (;;) {
    const int nrow = row + stride;
    const bool hn = nrow < MROWS;
    f32x4 xn[4], yn[4];
#pragma unroll
    for (int i = 0; i < 4; ++i) { xn[i] = f32x4{0.f, 0.f, 0.f, 0.f}; yn[i] = f32x4{0.f, 0.f, 0.f, 0.f}; }
    if (hn) load_row(nrow, xn, yn);
    if (mode != 0) {
      float ss = 0.f;
#pragma unroll
      for (int i = 0; i < 4; ++i)
        ss += yv[i].x * yv[i].x + yv[i].y * yv[i].y + yv[i].z * yv[i].z + yv[i].w * yv[i].w;
      ss = wave_sum(ss);
      const float r = rsqrtf(ss * (1.f / 1024.f) + EPSV) * alpha;
#pragma unroll
      for (int i = 0; i < 4; ++i) {
        xv[i].x += yv[i].x * r * gv[i].x; xv[i].y += yv[i].y * r * gv[i].y;
        xv[i].z += yv[i].z * r * gv[i].z; xv[i].w += yv[i].w * r * gv[i].w;
      }
    }
    float s2 = 0.f;
#pragma unroll
    for (int i = 0; i < 4; ++i) {
      s2 += xv[i].x * xv[i].x + xv[i].y * xv[i].y + xv[i].z * xv[i].z + xv[i].w * xv[i].w;
      *(f32x4*)(x + (size_t)row * 1024 + i * 256 + lane * 4) = xv[i];
      *(u32x2*)(xb + (size_t)row * 1024 + i * 256 + lane * 4) = pack4(xv[i].x, xv[i].y, xv[i].z, xv[i].w);
    }
    s2 = wave_sum(s2);
    if (lane == 0) rsx[row] = rsqrtf(s2 * (1.f / 1024.f) + EPSV);
    if (!hn) break;
    row = nrow;
#pragma unroll
    for (int i = 0; i < 4; ++i) { xv[i] = xn[i]; yv[i] = yn[i]; }
  }
}

__device__ void row_prep(const Params& p, int l) {
  const int lane = otid() & 63, wid = otid() >> 6;
  char* ws = p.ws;
  u16* h = (u16*)(ws + B_BIG);
  float* rsq = (float*)(ws + B_RSQ);
  const f32x2* ropeT = (const f32x2*)(ws + B_ROPE);
  u16* lat = (u16*)(ws + B_LAT);
  u16* kra = (u16*)(ws + B_KR);
  float* out = p.out;
  for (int row = blockIdx.x * 4 + wid; row < MROWS; row += gridDim.x * 4) {
    u16* hr = h + (size_t)row * HLD;
    const bool smp = row >= MPR;
    int b, t, pos;
    size_t latrow;
    if (!smp) { b = row >> 11; t = row & 2047; pos = t; latrow = row; }
    else { const int r2 = row - MPR; b = r2 >> 4; t = r2 & 15; pos = 2048 + t; latrow = (size_t)MPR + (size_t)b * SKEYS + 2048 + t; }
    const int lb = l * 8 + b;
    u32x4 ld_cq = u32x4{0u, 0u, 0u, 0u};
    if (lane < 48) ld_cq = *(const u32x4*)(hr + C_CQ + lane * 8);
    const u32x2 ld_kv = *(const u32x2*)(hr + C_KV + lane * 4);
    u16 ld_k1 = 0, ld_k2 = 0;
    if (lane < 16) { ld_k1 = hr[C_KR + lane]; ld_k2 = hr[C_KR + 16 + lane]; }
    const u32x2 ld_ga = *(const u32x2*)(hr + C_GA + lane * 4);
    const u32x2 ld_gg = *(const u32x2*)(hr + C_GG + lane * 4);
    const u32x2 ld_v = *(const u32x2*)(hr + C_V + lane * 4);
    const u32x2 ld_cg = *(const u32x2*)(hr + C_CG + lane * 4);
    const u32x2 ld_hd = *(const u32x2*)(hr + C_HD + lane * 4);
    {
      float ss = 0.f;
      if (lane < 48) {
        const u32x4 v = ld_cq;
        float f[4];
        unpack4(u32x2{v.x, v.y}, f); ss += f[0] * f[0] + f[1] * f[1] + f[2] * f[2] + f[3] * f[3];
        unpack4(u32x2{v.z, v.w}, f); ss += f[0] * f[0] + f[1] * f[1] + f[2] * f[2] + f[3] * f[3];
      }
      ss = wave_sum(ss);
      if (lane == 0) rsq[row] = rsqrtf(ss * (1.f / 384.f) + EPSV);
    }
    {
      float f[4];
      unpack4(ld_kv, f);
      float ss = wave_sum(f[0] * f[0] + f[1] * f[1] + f[2] * f[2] + f[3] * f[3]);
      const float r = rsqrtf(ss * (1.f / 256.f) + EPSV);
      const f32x4 g = *(const f32x4*)(p.in[15] + l * 256 + lane * 4);
      f32x4 o;
      o.x = f[0] * r * g.x; o.y = f[1] * r * g.y; o.z = f[2] * r * g.z; o.w = f[3] * r * g.w;
      float* op = smp ? out + O_LATS + ((size_t)lb * 16 + t) * 256 : out + O_LATP + ((size_t)lb * 2048 + t) * 256;
      *(f32x4*)(op + lane * 4) = o;
      *(u32x2*)(lat + latrow * 256 + lane * 4) = pack4(o.x, o.y, o.z, o.w);
    }
    if (lane < 16) {
      const float x1 = bf2f(ld_k1), x2 = bf2f(ld_k2);
      const f32x2 cs = ropeT[pos * 16 + lane];
      const float o1 = x1 * cs.x - x2 * cs.y, o2 = x2 * cs.x + x1 * cs.y;
      float* op = smp ? out + O_KRS + ((size_t)lb * 16 + t) * 32 : out + O_KRP + ((size_t)lb * 2048 + t) * 32;
      op[lane] = o1; op[lane + 16] = o2;
      kra[latrow * 32 + lane] = f2bf(o1);
      kra[latrow * 32 + 16 + lane] = f2bf(o2);
    }
    {
      float a[4], gg[4];
      unpack4(ld_ga, a);
      unpack4(ld_gg, gg);
      f32x4 o;
      o.x = a[0] * sigm(gg[0]); o.y = a[1] * sigm(gg[1]); o.z = a[2] * sigm(gg[2]); o.w = a[3] * sigm(gg[3]);
      *(u32x2*)(hr + C_GA + lane * 4) = pack4(o.x, o.y, o.z, o.w);
      if (!smp) {
        if (t >= 2018) *(f32x4*)(out + O_CBP + ((size_t)lb * 30 + (t - 2018)) * 256 + lane * 4) = o;
      } else {
        *(f32x4*)(out + O_CBS + ((size_t)lb * 30 + 14 + t) * 256 + lane * 4) = o;
        if (t < 14)
          *(f32x4*)(out + O_CBS + ((size_t)lb * 30 + t) * 256 + lane * 4) =
              *(const f32x4*)(p.in[4] + ((size_t)lb * 30 + 16 + t) * 256 + lane * 4);
      }
    }
    {
      float f[4];
      unpack4(ld_v, f);
      const float mean = wave_sum(f[0] + f[1] + f[2] + f[3]) * (1.f / 256.f);
      const float d0 = f[0] - mean, d1 = f[1] - mean, d2 = f[2] - mean, d3 = f[3] - mean;
      const float var = wave_sum(d0 * d0 + d1 * d1 + d2 * d2 + d3 * d3) * (1.f / 256.f);
      const float r = rsqrtf(var + EPSV);
      const f32x4 g = *(const f32x4*)(p.in[21] + l * 256 + lane * 4);
      const f32x4 bb = *(const f32x4*)(p.in[22] + l * 256 + lane * 4);
      f32x4 o;
      o.x = d0 * r * g.x + bb.x; o.y = d1 * r * g.y + bb.y; o.z = d2 * r * g.z + bb.z; o.w = d3 * r * g.w + bb.w;
      *(u32x2*)(hr + C_V + lane * 4) = pack4(o.x, o.y, o.z, o.w);
      if (smp) *(f32x4*)(out + O_VS + ((size_t)lb * 16 + t) * 256 + lane * 4) = o;
    }
    {
      float c[4], hd[4];
      unpack4(ld_cg, c);
      unpack4(ld_hd, hd);
      f32x4 o;
      o.x = c[0] * hd[0]; o.y = c[1] * hd[1]; o.z = c[2] * hd[2]; o.w = c[3] * hd[3];
      *(u32x2*)(hr + C_CG + lane * 4) = pack4(o.x, o.y, o.z, o.w);
      if (!smp) {
        if (t >= 2046) *(f32x4*)(out + O_CDP + ((size_t)lb * 2 + (t - 2046)) * 256 + lane * 4) = o;
      } else {
        if (t >= 14) *(f32x4*)(out + O_CDS + ((size_t)lb * 2 + (t - 14)) * 256 + lane * 4) = o;
      }
    }
  }
}

__device__ void conv_item(const Params& p, int l, int item, char* smem) {
  const int tid = otid(), lane = tid & 63, wid = tid >> 6;
  char* ws = p.ws;
  const u16* h = (const u16*)(ws + B_BIG);
  u16* ybp = (u16*)(ws + B_YB);
  u16* ydp = (u16*)(ws + B_YD);
  u16* X = (u16*)smem;
  float* Wc = (float*)(smem + 31744);
  const bool smp = item >= 512;
  int b, t0;
  size_t R0;
  if (!smp) { b = item >> 6; t0 = (item & 63) * 32; R0 = (size_t)b * 2048; }
  else { b = item - 512; t0 = 0; R0 = (size_t)MPR + b * 16; }
  const int lb = l * 8 + b;
  __syncthreads();
  {
    u32x4 xv[8];
    f32x4 wv[8];
    const f32x4* wsrc = (const f32x4*)(p.in[17] + (size_t)l * 31 * 256);
#pragma unroll
    for (int it = 0; it < 8; ++it) {
      const int ch = tid + 256 * it;
      const int i = ch >> 5, c8 = ch & 31;
      const int tt = t0 - 30 + i;
      u32x4 v = u32x4{0u, 0u, 0u, 0u};
      if (ch < 62 * 32) {
        if (!smp) {
          if (tt >= 0) v = *(const u32x4*)(h + (R0 + tt) * HLD + C_GA + c8 * 8);
        } else {
          if (tt < 0) {
            const float* sp = p.in[4] + ((size_t)lb * 30 + (30 + tt)) * 256 + c8 * 8;
            const f32x4 v0 = *(const f32x4*)sp, v1 = *(const f32x4*)(sp + 4);
            v.x = pk2(v0.x, v0.y); v.y = pk2(v0.z, v0.w); v.z = pk2(v1.x, v1.y); v.w = pk2(v1.z, v1.w);
          } else if (tt < 16) {
            v = *(const u32x4*)(h + (R0 + tt) * HLD + C_GA + c8 * 8);
          }
        }
      }
      xv[it] = v;
      wv[it] = ch < 1984 ? wsrc[ch] : f32x4{0.f, 0.f, 0.f, 0.f};
    }
#pragma unroll
    for (int it = 0; it < 8; ++it) {
      const int ch = tid + 256 * it;
      if (ch < 62 * 32) {
        *(u32x4*)(X + (ch >> 5) * 256 + (ch & 31) * 8) = xv[it];
        ((f32x4*)Wc)[ch] = wv[it];
      }
    }
  }
  __syncthreads();
  if (!smp || wid < 2) {
    const int tr0 = wid * 8;
    float acc[8][4];
    {
      const f32x4 bi = *(const f32x4*)(p.in[18] + l * 256 + lane * 4);
#pragma unroll
      for (int r = 0; r < 8; ++r) { acc[r][0] = bi.x; acc[r][1] = bi.y; acc[r][2] = bi.z; acc[r][3] = bi.w; }
    }
    {
      const f32x4 dw0 = *(const f32x4*)(p.in[25] + (size_t)l * 768 + lane * 4);
      const f32x4 dw1 = *(const f32x4*)(p.in[25] + (size_t)l * 768 + 256 + lane * 4);
      const f32x4 dw2 = *(const f32x4*)(p.in[25] + (size_t)l * 768 + 512 + lane * 4);
      float xf[10][4];
      u32x2 bgv[8];
#pragma unroll
      for (int q = 0; q < 10; ++q) {
        const int tq = t0 + tr0 + q - 2;
        if (tq >= 0) {
          unpack4(*(const u32x2*)(h + (R0 + tq) * HLD + C_CG + lane * 4), xf[q]);
        } else if (smp) {
          const f32x4 sv = *(const f32x4*)(p.in[5] + ((size_t)lb * 2 + (2 + tq)) * 256 + lane * 4);
          xf[q][0] = sv.x; xf[q][1] = sv.y; xf[q][2] = sv.z; xf[q][3] = sv.w;
        } else {
          xf[q][0] = xf[q][1] = xf[q][2] = xf[q][3] = 0.f;
        }
      }
#pragma unroll
      for (int r = 0; r < 8; ++r) bgv[r] = *(const u32x2*)(h + (R0 + t0 + tr0 + r) * HLD + C_BG + lane * 4);
#pragma unroll
      for (int r = 0; r < 8; ++r) {
        float bg[4];
        unpack4(bgv[r], bg);
        const float z0 = bg[0] * (dw2.x * xf[r + 2][0] + dw1.x * xf[r + 1][0] + dw0.x * xf[r][0]);
        const float z1 = bg[1] * (dw2.y * xf[r + 2][1] + dw1.y * xf[r + 1][1] + dw0.y * xf[r][1]);
        const float z2 = bg[2] * (dw2.z * xf[r + 2][2] + dw1.z * xf[r + 1][2] + dw0.z * xf[r][2]);
        const float z3 = bg[3] * (dw2.w * xf[r + 2][3] + dw1.w * xf[r + 1][3] + dw0.w * xf[r][3]);
        *(u32x2*)(ydp + (R0 + t0 + tr0 + r) * 256 + lane * 4) = pack4(z0, z1, z2, z3);
      }
    }
    for (int k = 0; k < 31; ++k) {
      const f32x4 w4 = *(const f32x4*)(Wc + k * 256 + lane * 4);
#pragma unroll
      for (int r = 0; r < 8; ++r) {
        float xv[4];
        unpack4(*(const u32x2*)(X + (tr0 + r + k) * 256 + lane * 4), xv);
        acc[r][0] += w4.x * xv[0]; acc[r][1] += w4.y * xv[1]; acc[r][2] += w4.z * xv[2]; acc[r][3] += w4.w * xv[3];
      }
    }
    const f32x4 lg = *(const f32x4*)(p.in[19] + l * 256 + lane * 4);
    const f32x4 lbb = *(const f32x4*)(p.in[20] + l * 256 + lane * 4);
#pragma unroll
    for (int r = 0; r < 8; ++r) {
      const int t = t0 + tr0 + r;
      const size_t row = R0 + t;
      const float mean = wave_sum(acc[r][0] + acc[r][1] + acc[r][2] + acc[r][3]) * (1.f / 256.f);
      const float d0 = acc[r][0] - mean, d1 = acc[r][1] - mean, d2 = acc[r][2] - mean, d3 = acc[r][3] - mean;
      const float var = wave_sum(d0 * d0 + d1 * d1 + d2 * d2 + d3 * d3) * (1.f / 256.f);
      const float rs = rsqrtf(var + EPSV);
      float y0 = d0 * rs * lg.x + lbb.x, y1 = d1 * rs * lg.y + lbb.y, y2 = d2 * rs * lg.z + lbb.z,
            y3 = d3 * rs * lg.w + lbb.w;
      y0 *= sigm(y0); y1 *= sigm(y1); y2 *= sigm(y2); y3 *= sigm(y3);
      *(u32x2*)(ybp + row * 256 + lane * 4) = pack4(y0, y1, y2, y3);
    }
  }
}

__device__ void gmlp_item(const Params& p, int l, int item, char* smem) {
  const int tid = otid(), lane = tid & 63, wid = tid >> 6, fr = lane & 15, fq = lane >> 4;
  char* ws = p.ws;
  const u16* h = (const u16*)(ws + B_BIG);
  u16* ycp = (u16*)(ws + B_YC);
  u16* vT = (u16*)smem;
  int b, g, nrows;
  size_t R0;
  if (item < 512) { b = item >> 6; const int n = (item >> 2) & 15; g = item & 3; R0 = (size_t)b * 2048 + n * 128; nrows = 128; }
  else { const int i2 = item - 512; b = i2 >> 2; g = i2 & 3; R0 = (size_t)MPR + b * 16; nrows = 16; }
  const float* Wg = p.in[23] + (size_t)(l * 4 + g) * 16384;
  const float* bs = p.in[24] + (size_t)(l * 4 + g) * 128;
  u32x4 fv[4];
#pragma unroll
  for (int it = 0; it < 4; ++it) {
    const int ch = tid + 256 * it, j = ch >> 3, c8 = ch & 7;
    fv[it] = u32x4{0u, 0u, 0u, 0u};
    if (j < nrows) fv[it] = *(const u32x4*)(h + (R0 + j) * HLD + C_V + g * 64 + c8 * 8);
  }
  f32x4 wq[2][4][2];
  float bsv[2][4];
  u16 uu[2][4][4];
#pragma unroll
  for (int mm = 0; mm < 2; ++mm) {
    const int m = wid * 2 + mm;
    const int kmax = (m * 16 < nrows) ? ((nrows == 16) ? 1 : (m < 4 ? 2 : 4)) : 0;
#pragma unroll
    for (int ks = 0; ks < 4; ++ks) {
      wq[mm][ks][0] = f32x4{0.f, 0.f, 0.f, 0.f};
      wq[mm][ks][1] = f32x4{0.f, 0.f, 0.f, 0.f};
      if (ks < kmax) {
        const float* wp = Wg + (size_t)(m * 16 + fr) * 128 + ks * 32 + fq * 8;
        wq[mm][ks][0] = *(const f32x4*)wp;
        wq[mm][ks][1] = *(const f32x4*)(wp + 4);
      }
    }
#pragma unroll
    for (int j = 0; j < 4; ++j) {
      const int i = m * 16 + fq * 4 + j;
      bsv[mm][j] = 0.f;
#pragma unroll
      for (int n = 0; n < 4; ++n) uu[mm][j][n] = 0;
      if (i < nrows) {
        bsv[mm][j] = bs[i];
#pragma unroll
        for (int n = 0; n < 4; ++n) uu[mm][j][n] = h[(R0 + i) * HLD + C_U + g * 64 + n * 16 + fr];
      }
    }
  }
  __syncthreads();
#pragma unroll
  for (int it = 0; it < 4; ++it) {
    const int ch = tid + 256 * it, j = ch >> 3, c8 = ch & 7;
    const u32x4 v = fv[it];
    u16* d = vT + (c8 * 8) * 136 + j;
    d[0 * 136] = (u16)(v.x & 0xffff); d[1 * 136] = (u16)(v.x >> 16);
    d[2 * 136] = (u16)(v.y & 0xffff); d[3 * 136] = (u16)(v.y >> 16);
    d[4 * 136] = (u16)(v.z & 0xffff); d[5 * 136] = (u16)(v.z >> 16);
    d[6 * 136] = (u16)(v.w & 0xffff); d[7 * 136] = (u16)(v.w >> 16);
  }
  __syncthreads();
  f32x4 acc[2][4];
#pragma unroll
  for (int mm = 0; mm < 2; ++mm)
#pragma unroll
    for (int n = 0; n < 4; ++n) acc[mm][n] = f32x4{0.f, 0.f, 0.f, 0.f};
#pragma unroll
  for (int mm = 0; mm < 2; ++mm) {
    const int m = wid * 2 + mm;
    if (m * 16 < nrows) {
      const int kmax = (nrows == 16) ? 1 : (m < 4 ? 2 : 4);
#pragma unroll
      for (int ks = 0; ks < 4; ++ks) {
        if (ks < kmax) {
          const f32x4 w0 = wq[mm][ks][0], w1 = wq[mm][ks][1];
          union { u32x4 u; bf16x8 v; } cv;
          cv.u.x = pk2(w0.x, w0.y); cv.u.y = pk2(w0.z, w0.w); cv.u.z = pk2(w1.x, w1.y); cv.u.w = pk2(w1.z, w1.w);
#pragma unroll
          for (int n = 0; n < 4; ++n) {
            const bf16x8 bv = *(const bf16x8*)(vT + (n * 16 + fr) * 136 + ks * 32 + fq * 8);
            acc[mm][n] = MFMA16(cv.v, bv, acc[mm][n]);
          }
        }
      }
    }
  }
#pragma unroll
  for (int mm = 0; mm < 2; ++mm) {
    const int m = wid * 2 + mm;
#pragma unroll
    for (int j = 0; j < 4; ++j) {
      const int i = m * 16 + fq * 4 + j;
      if (i < nrows) {
#pragma unroll
        for (int n = 0; n < 4; ++n) {
          const int c = g * 64 + n * 16 + fr;
          ycp[(R0 + i) * 256 + c] = f2bf(bf2f(uu[mm][j][n]) * (acc[mm][n][j] + bsv[mm][j]));
        }
      }
    }
  }
}

__device__ void attn_item(const Params& p, int idx, char* smem) {
  const int tid = otid(), lane = tid & 63, wid = tid >> 6, fr = lane & 15, fq = lane >> 4;
  char* ws = p.ws;
  const u16* qb = (const u16*)(ws + B_Q);
  const u16* Kn = (const u16*)(ws + B_KN);
  const u16* kra = (const u16*)(ws + B_KR);
  u16* ab = (u16*)(ws + B_A);
  int hh, ntiles, myt, nkeys, vstride;
  size_t qrow[2], krow0;
  const u16* Vp;
  const bool smp = idx < 64;
  if (smp) {
    const int b = idx >> 3; hh = idx & 7; ntiles = 33; myt = 33; nkeys = SKEYS; vstride = VSTR_S;
    qrow[0] = qrow[1] = (size_t)MPR + b * 16 + fr; krow0 = (size_t)MPR + (size_t)b * SKEYS;
    Vp = (const u16*)(ws + B_VTS) + (size_t)(b * 8 + hh) * 64 * VSTR_S;
  } else {
    const int i = idx - 64; const int pp = 15 - (i >> 6); const int b = (i & 63) >> 3; hh = i & 7;
    ntiles = 2 * pp + 2; myt = 2 * pp + 1 + (wid >> 1); nkeys = 2048; vstride = 2048;
    qrow[0] = (size_t)b * 2048 + pp * 128 + wid * 32 + fr; qrow[1] = qrow[0] + 16; krow0 = (size_t)b * 2048;
    Vp = (const u16*)(ws + B_VTP) + (size_t)(b * 8 + hh) * 64 * 2048;
  }
  const u16* Kp = Kn + krow0 * 512 + hh * 64;
  const u16* KRp = kra + krow0 * 32;
  bf16x8 qf[2][3];
#pragma unroll
  for (int qs = 0; qs < 2; ++qs)
#pragma unroll
    for (int ks = 0; ks < 3; ++ks) qf[qs][ks] = *(const bf16x8*)(qb + qrow[qs] * 768 + hh * 96 + ks * 32 + fq * 8);
  char* Ks = smem;
  char* Vs = smem + 26624;
  const u32x4 z4 = u32x4{0u, 0u, 0u, 0u};
  u32x4 rk[2], rr, rv[2];
#define ATT_LOAD(kt)                                                                                   \
  {                                                                                                    \
    _Pragma("unroll") for (int i = 0; i < 2; ++i) {                                                    \
      const int ch = tid + 256 * i; const int key = (kt) * 64 + (ch >> 3), c8 = ch & 7;                \
      rk[i] = key < nkeys ? *(const u32x4*)(Kp + (size_t)key * 512 + c8 * 8) : z4;                     \
      const int dim = ch >> 3; const int k0 = (kt) * 64 + c8 * 8;                                      \
      rv[i] = k0 < nkeys ? *(const u32x4*)(Vp + (size_t)dim * vstride + k0) : z4;                      \
    }                                                                                                  \
    { const int key = (kt) * 64 + (tid >> 2), c4 = tid & 3;                                            \
      rr = key < nkeys ? *(const u32x4*)(KRp + (size_t)key * 32 + c4 * 8) : z4; }                      \
  }
#define ATT_STORE(buf)                                                                                 \
  {                                                                                                    \
    _Pragma("unroll") for (int i = 0; i < 2; ++i) {                                                    \
      const int ch = tid + 256 * i;                                                                    \
      *(u32x4*)(Ks + (buf) * 13312 + (ch >> 3) * 208 + (ch & 7) * 16) = rk[i];                         \
      *(u32x4*)(Vs + (buf) * 9216 + (ch >> 3) * 144 + (ch & 7) * 16) = rv[i];                          \
    }                                                                                                  \
    *(u32x4*)(Ks + (buf) * 13312 + (tid >> 2) * 208 + 128 + (tid & 3) * 16) = rr;                      \
  }
  ATT_LOAD(0)
  __syncthreads();
  ATT_STORE(0)
  __syncthreads();
  f32x4 o[2][4];
#pragma unroll
  for (int qs = 0; qs < 2; ++qs)
#pragma unroll
    for (int n = 0; n < 4; ++n) o[qs][n] = f32x4{0.f, 0.f, 0.f, 0.f};
  float mrun[2] = {-1e30f, -1e30f}, lrun[2] = {0.f, 0.f};
  for (int kt = 0; kt < ntiles; ++kt) {
    const int cur = kt & 1;
    if (kt + 1 < ntiles) ATT_LOAD(kt + 1)
    if (kt < myt) {
      f32x4 s[2][4];
      const char* kb = Ks + cur * 13312 + fr * 208 + fq * 16;
#pragma unroll
      for (int t = 0; t < 4; ++t) {
        s[0][t] = f32x4{0.f, 0.f, 0.f, 0.f};
        s[1][t] = f32x4{0.f, 0.f, 0.f, 0.f};
#pragma unroll
        for (int ks = 0; ks < 3; ++ks) {
          const bf16x8 a = *(const bf16x8*)(kb + t * 16 * 208 + ks * 64);
          s[0][t] = MFMA16(a, qf[0][ks], s[0][t]);
          s[1][t] = MFMA16(a, qf[1][ks], s[1][t]);
        }
      }
      if (kt * 64 + 64 > nkeys) {
#pragma unroll
        for (int t = 0; t < 4; ++t)
#pragma unroll
          for (int j = 0; j < 4; ++j)
            if (kt * 64 + t * 16 + fq * 4 + j >= nkeys) { s[0][t][j] = -1e30f; s[1][t][j] = -1e30f; }
      }
      bf16x8 pb[2][2];
#pragma unroll
      for (int qs = 0; qs < 2; ++qs) {
        float mx = s[qs][0][0];
#pragma unroll
        for (int t = 0; t < 4; ++t)
#pragma unroll
          for (int j = 0; j < 4; ++j) mx = fmaxf(mx, s[qs][t][j]);
        mx = fmaxf(mx, __shfl_xor(mx, 16, 64));
        mx = fmaxf(mx, __shfl_xor(mx, 32, 64));
        const float mnew = fmaxf(mrun[qs], mx);
        const float alpha = __builtin_amdgcn_exp2f(mrun[qs] - mnew);
        mrun[qs] = mnew;
        float psum = 0.f;
#pragma unroll
        for (int t = 0; t < 4; ++t)
#pragma unroll
          for (int j = 0; j < 4; ++j) {
            const float pv = __builtin_amdgcn_exp2f(s[qs][t][j] - mnew);
            s[qs][t][j] = pv;
            psum += pv;
          }
        lrun[qs] = lrun[qs] * alpha + psum;
#pragma unroll
        for (int n = 0; n < 4; ++n) {
          o[qs][n][0] *= alpha; o[qs][n][1] *= alpha; o[qs][n][2] *= alpha; o[qs][n][3] *= alpha;
        }
#pragma unroll
        for (int s2 = 0; s2 < 2; ++s2) {
          union { u32x4 u; bf16x8 v; } cv;
          cv.u.x = pk2(s[qs][2 * s2][0], s[qs][2 * s2][1]); cv.u.y = pk2(s[qs][2 * s2][2], s[qs][2 * s2][3]);
          cv.u.z = pk2(s[qs][2 * s2 + 1][0], s[qs][2 * s2 + 1][1]);
          cv.u.w = pk2(s[qs][2 * s2 + 1][2], s[qs][2 * s2 + 1][3]);
          pb[qs][s2] = cv.v;
        }
      }
      const char* vb = Vs + cur * 9216 + fr * 144 + fq * 8;
#pragma unroll
      for (int n = 0; n < 4; ++n)
#pragma unroll
        for (int s2 = 0; s2 < 2; ++s2) {
          const u32x2 lo = *(const u32x2*)(vb + n * 16 * 144 + s2 * 64);
          const u32x2 hi = *(const u32x2*)(vb + n * 16 * 144 + s2 * 64 + 32);
          union { u32x4 u; bf16x8 v; } cv;
          cv.u.x = lo.x; cv.u.y = lo.y; cv.u.z = hi.x; cv.u.w = hi.y;
          o[0][n] = MFMA16(cv.v, pb[0][s2], o[0][n]);
          o[1][n] = MFMA16(cv.v, pb[1][s2], o[1][n]);
        }
    }
    if (kt + 1 < ntiles) ATT_STORE(cur ^ 1)
    __syncthreads();
  }
#pragma unroll
  for (int qs = 0; qs < 2; ++qs) {
    float lr = lrun[qs];
    lr += __shfl_xor(lr, 16, 64);
    lr += __shfl_xor(lr, 32, 64);
    const float inv = 1.f / lr;
    if (!smp || (wid == 0 && qs == 0)) {
#pragma unroll
      for (int n = 0; n < 4; ++n)
        *(u32x2*)(ab + qrow[qs] * 512 + hh * 64 + n * 16 + fq * 4) =
            pack4(o[qs][n][0] * inv, o[qs][n][1] * inv, o[qs][n][2] * inv, o[qs][n][3] * inv);
    }
  }
#undef ATT_LOAD
#undef ATT_STORE
}

__device__ void run_phase(const Params& p, int ph, char* smem, int* s_item, int rep) {
  char* ws = p.ws;
  const int nb = gridDim.x, bid = blockIdx.x;
  if (ph == 0 && PM(13)) {
    for (int i = bid * 256 + otid(); i < 2064 * 16; i += nb * 256) {
      const int pos = i >> 4, j = i & 15;
      const float inv = expf(-logf(10000.0f) * (float)j / 16.0f);
      const float ang = (float)pos * inv;
      float sn, cs;
      sincosf(ang, &sn, &cs);
      ((f32x2*)(ws + B_ROPE))[i] = f32x2{cs, sn};
    }
    if (bid == 0 && otid() < 64) ((int*)(ws + B_CNT))[otid()] = 0;
    if (bid == 0) for (int i = otid(); i < XCD_BAR_WORDS; i += 256) ((unsigned*)(ws + B_BAR))[i] = 0u;
    row_update(p, 0, 0.f, nullptr);
    convert_layer(p, 0, smem);
    return;
  }
  const int l = (ph - 1) / 13, st = (ph - 1) % 13;
  const u16* xb = (const u16*)(ws + B_XB);
  const float* rsx = (const float*)(ws + B_RSX);
  u16* big = (u16*)(ws + B_BIG);
  float* y = (float*)(ws + B_Y);
  switch (st) {
    case 0:
    case 10: if (PM(0)) {
      const u16* W = (const u16*)(ws + (st == 0 ? W_GU1 : W_GU2));
      zero_y_sample(y);
      ffn_up_phase(xb, W, rsx, big, smem);
    } break;
    case 1:
    case 11: if (PM(1)) {
      const u16* W = (const u16*)(ws + (st == 1 ? W_D1 : W_D2));
      gemm_f32_phase(big, DFF, DFF, W, y, 11, smem);
    } break;
    case 2: if (PM(2)) row_update(p, 1, 0.5f, p.in[7] + l * 1024); break;
    case 3: if (PM(3)) {
      const u16* W = (const u16*)(ws + W_IN);
      win_phase(xb, W, rsx, big, smem);
    } break;
    case 4: if (PM(4)) row_prep(p, l); break;
    case 5: if (PM(5)) {
      const int n_q = 129 * 6, n_kv = 257 * 8, n_cv = 520, n_gm = 544;
      for (int t = bid; t < n_q + n_kv + n_cv + n_gm; t += nb) {
        int u = t;
        if (u < n_cv) {
          if (PM(18)) conv_item(p, l, u, smem);
        } else if ((u -= n_cv) < n_gm) {
          if (PM(19)) gmlp_item(p, l, u, smem);
        } else if ((u -= n_gm) < n_q) {
          if (PM(17))
          q_tile(big, (const u16*)(ws + W_UQ), (const float*)(ws + B_RSQ), (const f32x2*)(ws + B_ROPE),
                 (u16*)(ws + B_Q), u / 6, u % 6, smem);
        } else {
          u -= n_q;
          if (PM(16))
          kv_tile((const u16*)(ws + B_LAT), (const u16*)(ws + W_UKV), (u16*)(ws + B_KN), (u16*)(ws + B_VTP),
                  (u16*)(ws + B_VTS), u >> 3, u & 7, smem);
        }
      }
    } break;
    case 6: if (PM(6)) {
      int* cnt = (int*)(ws + B_CNT) + l + 4 * rep;
      for (;;) {
        if (otid() == 0) *s_item = atomicAdd(cnt, 1);
        __syncthreads();
        const int idx = *s_item;
        __syncthreads();
        if (idx >= 1088) break;
        attn_item(p, idx, smem);
      }
    } break;
    case 7: if (PM(7)) {
      zero_y_sample(y);
      {
        const int bound = 8 * ((129 * 16 + 7) >> 3);
        int i = bid, mt, nt;
        bool have = next_tile(i, nb, bound, 129, 16, mt, nt), pre = false;
        while (have) {
          int i2 = i + nb, mt2 = 0, nt2 = 0;
          const bool hn = next_tile(i2, nb, bound, 129, 16, mt2, nt2);
          merge_tile((const u16*)(ws + B_A), (const u16*)(ws + B_YB), (const u16*)(ws + B_YC), (const u16*)(ws + B_YD),
                     (const u16*)(ws + W_BRA), (const u16*)(ws + W_BRB), (const u16*)(ws + W_BRC),
                     (const u16*)(ws + W_BRD), big, (u16*)(ws + B_MG), mt, nt, pre, hn, mt2, nt2, smem);
          pre = hn; i = i2; mt = mt2; nt = nt2; have = hn;
        }
      }
    } break;
    case 8: if (PM(8)) {
      gemm_f32_phase((const u16*)(ws + B_MG), 1024, 1024, (const u16*)(ws + W_O), y, 4, smem);
    } break;
    case 9: if (PM(2)) row_update(p, 1, 1.0f, p.in[11] + l * 1024); break;
    case 12:
      if (PM(2)) row_update(p, 1, 0.5f, p.in[32] + l * 1024);
      if (PM(12)) if (l + 1 < 4) convert_layer(p, l + 1, smem);
      break;
    default: break;
  }
}

constexpr int NPHASES = 1 + 13 * 4;

__global__ void __launch_bounds__(256, 2) mega(Params p, int ph0, int ph1) {
  __shared__ __attribute__((aligned(16))) char smem[65536];
  __shared__ u32x4 s_misc;
  cg::grid_group grid = cg::this_grid();
  if (threadIdx.x == 0) s_misc = u32x4{0u, 0u, 0u, 0u};
  __syncthreads();
  int* s_item = (int*)&s_misc + 2;
  XcdBarrier xb;
  xb.bar = (unsigned*)(p.ws + B_BAR); xb.x = 0u; xb.st = (volatile LAS unsigned*)&s_misc;
  for (int ph = ph0; ph < ph1; ++ph) {
    int reps = 1;
#ifdef DUPMASK
    if (ph > 0 && ((DUPMASK >> ((ph - 1) % 13)) & 1)) reps = 2;
#endif
    for (int rep = 0; rep < reps; ++rep) run_phase(p, ph, smem, s_item, rep);
    if (ph + 1 < ph1) {
      if (ph == ph0) {
        grid.sync();
        xb = xcd_barrier_post((unsigned*)(p.ws + B_BAR), (volatile LAS unsigned*)&s_misc);
      } else {
        xcd_barrier(xb);
      }
    }
  }
}

extern "C" void kernel_launch(void* const* d_in, const int* in_sizes, int n_in, void* d_out, int out_size, void* d_ws,
                              size_t ws_size, hipStream_t stream) {
  (void)in_sizes; (void)n_in; (void)out_size;
  if (ws_size < WS_NEED) { fprintf(stderr, "ws too small: %zu < %zu\n", ws_size, (size_t)WS_NEED); return; }
  static int grid_blocks = 0;
  if (!grid_blocks) {
    int dev = 0, cus = 0, per_cu = 0;
    hipGetDevice(&dev);
    hipDeviceGetAttribute(&cus, hipDeviceAttributeMultiprocessorCount, dev);
    hipOccupancyMaxActiveBlocksPerMultiprocessor(&per_cu, mega, 256, 0);
    if (per_cu < 1) per_cu = 1;
    if (per_cu > 2) per_cu = 2;
    grid_blocks = cus * per_cu;
  }
  Params p{};
  for (int i = 0; i < 35; ++i) p.in[i] = (const float*)d_in[i];
  p.out = (float*)d_out;
  p.ws = (char*)d_ws;
#if COOP
  int ph0 = 0, ph1 = NPHASES;
  void* args[] = {&p, &ph0, &ph1};
  hipError_t e = hipLaunchCooperativeKernel((void*)mega, dim3(grid_blocks), dim3(256), args, 0, stream);
  if (e != hipSuccess) fprintf(stderr, "cooperative launch failed: %s (grid %d)\n", hipGetErrorString(e), grid_blocks);
#else
  for (int ph = 0; ph < NPHASES; ++ph) mega<<<dim3(grid_blocks), dim3(256), 0, stream>>>(p, ph, ph + 1);
#endif
}
```

```cpp
#include <hip/hip_runtime.h>
#include <hip/hip_cooperative_groups.h>
#include <cstdio>
namespace cg = cooperative_groups;

#ifndef COOP
#define COOP 1
#endif
#ifndef PMASK
#define PMASK 0xffffffffu
#endif
#define PM(k) ((PMASK >> (k)) & 1u)

typedef unsigned short u16;
using bf16x8 = __attribute__((ext_vector_type(8))) short;
using f32x4 = __attribute__((ext_vector_type(4))) float;
using f32x2 = __attribute__((ext_vector_type(2))) float;
using u32x4 = __attribute__((ext_vector_type(4))) unsigned;
using u32x2 = __attribute__((ext_vector_type(2))) unsigned;

#define EPSV 1e-6f
#define MFMA16(a, b, c) __builtin_amdgcn_mfma_f32_16x16x32_bf16((a), (b), (c), 0, 0, 0)

struct Params {
  const float* in[35];
  float* out;
  char* ws;
};

constexpr int MROWS = 16512;
constexpr int MPR = 16384;
constexpr int HLD = 6656;
constexpr int DIN = 6560;
constexpr int DFF = 2816;
constexpr int C_CQ = 0, C_KV = 384, C_KR = 640, C_GA = 672, C_GG = 928, C_U = 1184, C_V = 1440, C_BG = 1696,
              C_CG = 1952, C_HD = 2208, C_GATE = 2464;
constexpr int KVROWS = 32896;
constexpr int SKEYS = 2064;
constexpr int VSTR_S = 2112;

constexpr size_t O_YP = 0;
constexpr size_t O_YS = O_YP + 16777216;
constexpr size_t O_LATP = O_YS + 131072;
constexpr size_t O_KRP = O_LATP + 16777216;
constexpr size_t O_CBP = O_KRP + 2097152;
constexpr size_t O_CDP = O_CBP + 245760;
constexpr size_t O_LATS = O_CDP + 16384;
constexpr size_t O_KRS = O_LATS + 131072;
constexpr size_t O_CBS = O_KRS + 16384;
constexpr size_t O_VS = O_CBS + 245760;
constexpr size_t O_CDS = O_VS + 131072;

constexpr size_t W_GU1 = 0;
constexpr size_t W_D1 = W_GU1 + (size_t)5632 * 1024 * 2;
constexpr size_t W_IN = W_D1 + (size_t)1024 * 2816 * 2;
constexpr size_t W_UQ = W_IN + (size_t)HLD * 1024 * 2;
constexpr size_t W_UKV = W_UQ + (size_t)768 * 384 * 2;
constexpr size_t W_BRA = W_UKV + (size_t)1024 * 256 * 2;
constexpr size_t W_BRB = W_BRA + (size_t)1024 * 512 * 2;
constexpr size_t W_BRC = W_BRB + (size_t)1024 * 256 * 2;
constexpr size_t W_BRD = W_BRC + (size_t)1024 * 256 * 2;
constexpr size_t W_O = W_BRD + (size_t)1024 * 256 * 2;
constexpr size_t W_GU2 = W_O + (size_t)1024 * 1024 * 2;
constexpr size_t W_D2 = W_GU2 + (size_t)5632 * 1024 * 2;
constexpr size_t B_XB = W_D2 + (size_t)1024 * 2816 * 2;
constexpr size_t B_RSX = B_XB + (size_t)MROWS * 1024 * 2;
constexpr size_t B_RSQ = B_RSX + (size_t)MROWS * 4;
constexpr size_t B_ROPE = B_RSQ + (size_t)MROWS * 4;
constexpr size_t B_CNT = B_ROPE + (size_t)2064 * 16 * 8;
constexpr size_t B_BAR = B_CNT + 256;
constexpr size_t B_BIG = B_BAR + 16384;
constexpr size_t B_Y = B_BIG + (size_t)MROWS * HLD * 2;
constexpr size_t B_Q = B_Y;
constexpr size_t B_KN = B_Q + (size_t)MROWS * 768 * 2;
constexpr size_t B_VTP = B_KN + (size_t)KVROWS * 512 * 2;
constexpr size_t B_VTS = B_VTP + (size_t)64 * 64 * 2048 * 2;
constexpr size_t B_LAT = B_VTS + (size_t)64 * 64 * VSTR_S * 2;
constexpr size_t B_KR = B_LAT + (size_t)KVROWS * 256 * 2;
constexpr size_t B_A = B_KR + (size_t)KVROWS * 32 * 2;
constexpr size_t B_YB = B_A + (size_t)MROWS * 512 * 2;
constexpr size_t B_YC = B_YB + (size_t)MROWS * 256 * 2;
constexpr size_t B_YD = B_YC + (size_t)MROWS * 256 * 2;
constexpr size_t B_MG = B_YD + (size_t)MROWS * 256 * 2;
constexpr size_t WS_NEED = B_MG + (size_t)MROWS * 1024 * 2;
static_assert(B_Y + (size_t)MROWS * 1024 * 4 <= B_VTS, "y alias overflow");

__device__ __forceinline__ int otid() { int t = threadIdx.x; asm volatile("" : "+v"(t)); return t; }
__device__ __forceinline__ u16 f2bf(float f) { return __builtin_bit_cast(u16, (__bf16)f); }
__device__ __forceinline__ float bf2f(u16 h) { return __uint_as_float(((unsigned)h) << 16); }
typedef __bf16 hwbf16x2 __attribute__((ext_vector_type(2)));
__device__ __forceinline__ unsigned pk2(float a, float b) {
  f32x2 v = {a, b};
  return __builtin_bit_cast(unsigned, __builtin_convertvector(v, hwbf16x2));
}
__device__ __forceinline__ u32x2 pack4(float a, float b, float c, float d) {
  u32x2 r; r.x = pk2(a, b); r.y = pk2(c, d); return r;
}
__device__ __forceinline__ void unpack4(u32x2 v, float (&f)[4]) {
  f[0] = __uint_as_float(v.x << 16); f[1] = __uint_as_float(v.x & 0xffff0000u);
  f[2] = __uint_as_float(v.y << 16); f[3] = __uint_as_float(v.y & 0xffff0000u);
}
__device__ __forceinline__ float wave_sum(float v) {
#pragma unroll
  for (int o = 32; o > 0; o >>= 1) v += __shfl_xor(v, o, 64);
  return v;
}
__device__ __forceinline__ float sigm(float x) { return __builtin_amdgcn_rcpf(1.f + __expf(-x)); }

#define XB_TMO      128
#define XB_XCNT(j)  (256  + 64 * (j))
#define XB_XSUB(j)  (1280 + 64 * (j))
#define XB_XGEN(j)  (2304 + 64 * (j))
#define XB_TOP      3328
#define XB_TOPGEN   3392
#define XCD_BAR_WORDS 3456
#define XB_SPIN_CAP (1u << 18)
#define LAS __attribute__((address_space(3)))
__device__ __forceinline__ unsigned xb_ld(unsigned* p) { return __hip_atomic_load(p, __ATOMIC_RELAXED, __HIP_MEMORY_SCOPE_AGENT); }
__device__ __forceinline__ unsigned xb_add(unsigned* p, unsigned v) { return __hip_atomic_fetch_add(p, v, __ATOMIC_RELAXED, __HIP_MEMORY_SCOPE_AGENT); }
__device__ __forceinline__ unsigned xb_xcc_id() { return (unsigned)__builtin_amdgcn_s_getreg((3 << 11) | 20) & 0xFu; }
#define XB_SPIN(cond, bar) do { unsigned _sp = 0; while (cond) { __builtin_amdgcn_s_sleep(1); \
    if ((++_sp & 255u) == 0u) { if (xb_ld(&(bar)[XB_TMO])) break; if (_sp > XB_SPIN_CAP) { atomicAdd(&(bar)[XB_TMO], 1u); break; } } } } while (0)
struct XcdBarrier { unsigned* bar; unsigned x; volatile LAS unsigned* st; };
__device__ __forceinline__ XcdBarrier xcd_barrier_post(unsigned* bar, volatile LAS unsigned* st) {
  XcdBarrier b; b.bar = bar; b.x = xb_xcc_id(); b.st = st;
  if (threadIdx.x == 0) (void)xb_add(&bar[XB_XCNT(b.x)], 1u);
  return b;
}
__device__ __forceinline__ void xcd_barrier_complete(unsigned* bar, unsigned x, unsigned& nloc, unsigned& nx) {
  const unsigned G = gridDim.x * gridDim.y * gridDim.z;
  unsigned sum, cnt, mine, sp = 0u;
  for (;;) {
    sum = 0u; cnt = 0u; mine = 0u;
#pragma unroll
    for (unsigned j = 0; j < 16; ++j) { const unsigned c = xb_ld(&bar[XB_XCNT(j)]); sum += c; cnt += (c > 0u) ? 1u : 0u; mine = (j == x) ? c : mine; }
    if (sum == G) break;
    __builtin_amdgcn_s_sleep(1);
    if ((++sp & 255u) == 0u) { if (xb_ld(&bar[XB_TMO])) break; if (sp > XB_SPIN_CAP) { atomicAdd(&bar[XB_TMO], 1u); break; } }
  }
  nloc = mine > 0u ? mine : 1u; nx = cnt > 0u ? cnt : 1u;
}
__device__ __forceinline__ void xcd_barrier(const XcdBarrier& b) {
  asm volatile("s_waitcnt vmcnt(0)" ::: "memory");
  __syncthreads();
  if (threadIdx.x == 0) {
    unsigned* bar = b.bar;
    __builtin_amdgcn_s_waitcnt(0);
    unsigned nloc = b.st[0], nx = b.st[1];
    if (nloc == 0u) { xcd_barrier_complete(bar, b.x, nloc, nx); b.st[0] = nloc; b.st[1] = nx; }
    const unsigned old = xb_add(&bar[XB_XSUB(b.x)], 1u);
    const unsigned gen = old / nloc;
    if (old + 1u == (gen + 1u) * nloc) {
      __builtin_amdgcn_fence(__ATOMIC_RELEASE, "agent");
      asm volatile("s_waitcnt vmcnt(0)" ::: "memory");
      const unsigned og = xb_add(&bar[XB_TOP], 1u);
      const unsigned tg = og / nx;
      if (og + 1u == (tg + 1u) * nx) xb_add(&bar[XB_TOPGEN], 1u);
      else XB_SPIN(xb_ld(&bar[XB_TOPGEN]) == tg, bar);
      __builtin_amdgcn_fence(__ATOMIC_ACQUIRE, "agent");
      xb_add(&bar[XB_XGEN(b.x)], 1u);
      asm volatile("s_waitcnt vmcnt(0)" ::: "memory");
    } else {
      XB_SPIN(xb_ld(&bar[XB_XGEN(b.x)]) == gen, bar);
      __builtin_amdgcn_fence(__ATOMIC_ACQUIRE, "agent");
      asm volatile("s_waitcnt vmcnt(0)" ::: "memory");
    }
  }
  __syncthreads();
}

#define DSR(dst, addr, OFF) asm volatile("ds_read_b128 %0, %1 offset:" #OFF : "=v"(dst) : "v"(addr))
__device__ __forceinline__ unsigned lds_addr(const char* p) { return (unsigned)(size_t)(LAS const char*)p; }

__device__ __forceinline__ int lds_off(int r, int c) {
  int st = (r >> 4) * 2 + (c >> 5), rr = r & 15, cc = c & 31, ob = rr * 64 + cc * 2;
  return st * 1024 + (ob ^ (((ob >> 9) & 1) << 5));
}

template <int NN>
__device__ __forceinline__ void gemm_first(const u16* __restrict__ A, int lda, const u16* __restrict__ Bt, int ldb,
                                           int row0, int col0, char* smem) {
  const int tid = otid(), lane = tid & 63, wid = tid >> 6;
  const int l2 = lane ^ ((lane >> 5) << 1);
  const int Rl = (wid >> 1) * 16 + (l2 >> 2), Cl = (wid & 1) * 32 + (l2 & 3) * 8;
  const u16* ag = A + (size_t)(row0 + Rl) * lda + Cl;
  const u16* bg = Bt + (size_t)(col0 + Rl) * ldb + Cl;
  const size_t astep = (size_t)32 * lda, bstep = (size_t)32 * ldb;
  char* dA = smem + tid * 16;
  char* dB = smem + 32768 + tid * 16;
#pragma unroll
  for (int i = 0; i < 4; ++i)
    __builtin_amdgcn_global_load_lds((const unsigned*)(ag + i * astep), (LAS unsigned*)(dA + i * 4096), 16, 0, 0);
#pragma unroll
  for (int i = 0; i < NN; ++i)
    __builtin_amdgcn_global_load_lds((const unsigned*)(bg + i * bstep), (LAS unsigned*)(dB + i * 4096), 16, 0, 0);
}

template <int NN>
__device__ __forceinline__ void gemm_main(const u16* __restrict__ A, int lda, const u16* __restrict__ Bt, int ldb,
                                          int K, int row0, int col0, f32x4 (&acc)[4][NN], char* smem,
                                          bool pre = false) {
  const int tid = otid(), lane = tid & 63, wid = tid >> 6, wr = wid >> 1, wc = wid & 1;
  const int fr = lane & 15, fq = lane >> 4;
  const int l2 = lane ^ ((lane >> 5) << 1);
  const int Rl = (wid >> 1) * 16 + (l2 >> 2), Cl = (wid & 1) * 32 + (l2 & 3) * 8;
  const u16* ag = A + (size_t)(row0 + Rl) * lda + Cl;
  const u16* bg = Bt + (size_t)(col0 + Rl) * ldb + Cl;
  const size_t astep = (size_t)32 * lda, bstep = (size_t)32 * ldb;
  const int rbase = (fr * 64 + fq * 16) ^ (((fr >> 3) & 1) << 5);
  char* sA = smem;
  char* sB = smem + 32768;
  char* dA = sA + tid * 16;
  char* dB = sB + tid * 16;
#define GLDS(gp, lp) __builtin_amdgcn_global_load_lds((const unsigned*)(gp), (LAS unsigned*)(lp), 16, 0, 0)
  if (!pre) {
    __syncthreads();
#pragma unroll
    for (int i = 0; i < 4; ++i) GLDS(ag + i * astep, dA + i * 4096);
#pragma unroll
    for (int i = 0; i < NN; ++i) GLDS(bg + i * bstep, dB + i * 4096);
  }
  asm volatile("s_waitcnt vmcnt(0)" ::: "memory");
  __syncthreads();
  const int nk = K >> 6;
  for (int kt = 0; kt < nk; ++kt) {
    const int cur = kt & 1;
    if (kt + 1 < nk) {
      const int ko = (kt + 1) * 64;
      char* na = dA + (cur ^ 1) * 16384;
      char* nb = dB + (cur ^ 1) * 16384;
#pragma unroll
      for (int i = 0; i < 4; ++i) GLDS(ag + i * astep + ko, na + i * 4096);
#pragma unroll
      for (int i = 0; i < NN; ++i) GLDS(bg + i * bstep + ko, nb + i * 4096);
    }
    const char* a_s = sA + cur * 16384 + rbase + wr * 8192;
    const char* b_s = sB + cur * 16384 + rbase + wc * (NN * 2048);
    {
      const unsigned aaddr = lds_addr(a_s), baddr = lds_addr(b_s);
      bf16x8 af[2][4], bfv[2][NN];
      DSR(af[0][0], aaddr, 0); DSR(af[0][1], aaddr, 2048); DSR(af[0][2], aaddr, 4096); DSR(af[0][3], aaddr, 6144);
      DSR(bfv[0][0], baddr, 0); DSR(bfv[0][1], baddr, 2048);
      if (NN == 4) { DSR(bfv[0][NN - 2], baddr, 4096); DSR(bfv[0][NN - 1], baddr, 6144); }
      DSR(af[1][0], aaddr, 1024); DSR(af[1][1], aaddr, 3072); DSR(af[1][2], aaddr, 5120); DSR(af[1][3], aaddr, 7168);
      DSR(bfv[1][0], baddr, 1024); DSR(bfv[1][1], baddr, 3072);
      if (NN == 4) { DSR(bfv[1][NN - 2], baddr, 5120); DSR(bfv[1][NN - 1], baddr, 7168); }
      if (NN == 4) {
        asm volatile("s_waitcnt lgkmcnt(8)"
                     : "+v"(af[0][0]), "+v"(af[0][1]), "+v"(af[0][2]), "+v"(af[0][3]), "+v"(bfv[0][0]),
                       "+v"(bfv[0][1]), "+v"(bfv[0][NN - 2]), "+v"(bfv[0][NN - 1]));
      } else {
        asm volatile("s_waitcnt lgkmcnt(6)"
                     : "+v"(af[0][0]), "+v"(af[0][1]), "+v"(af[0][2]), "+v"(af[0][3]), "+v"(bfv[0][0]),
                       "+v"(bfv[0][1]));
      }
#pragma unroll
      for (int m = 0; m < 4; ++m)
#pragma unroll
        for (int n = 0; n < NN; ++n) acc[m][n] = MFMA16(af[0][m], bfv[0][n], acc[m][n]);
      if (NN == 4) {
        asm volatile("s_waitcnt lgkmcnt(0)"
                     : "+v"(af[1][0]), "+v"(af[1][1]), "+v"(af[1][2]), "+v"(af[1][3]), "+v"(bfv[1][0]),
                       "+v"(bfv[1][1]), "+v"(bfv[1][NN - 2]), "+v"(bfv[1][NN - 1]));
      } else {
        asm volatile("s_waitcnt lgkmcnt(0)"
                     : "+v"(af[1][0]), "+v"(af[1][1]), "+v"(af[1][2]), "+v"(af[1][3]), "+v"(bfv[1][0]),
                       "+v"(bfv[1][1]));
      }
#pragma unroll
      for (int m = 0; m < 4; ++m)
#pragma unroll
        for (int n = 0; n < NN; ++n) acc[m][n] = MFMA16(af[1][m], bfv[1][n], acc[m][n]);
      __builtin_amdgcn_sched_barrier(0);
    }
    asm volatile("s_waitcnt vmcnt(0)" ::: "memory");
    __syncthreads();
  }
#undef GLDS
}

#define ZERO_ACC(acc)                                  \
  _Pragma("unroll") for (int m_ = 0; m_ < 4; ++m_)     \
  _Pragma("unroll") for (int n_ = 0; n_ < 4; ++n_) acc[m_][n_] = f32x4{0.f, 0.f, 0.f, 0.f};

#define TILE_IDS                                                            \
  const int tid = otid(), lane = tid & 63, wid = tid >> 6;             \
  const int wr = wid >> 1, wc = wid & 1, fr = lane & 15, fq = lane >> 4;    \
  (void)tid; (void)lane; (void)wid; (void)wr; (void)wc; (void)fr; (void)fq;

__device__ void ffn_up_tile(const u16* xb, const u16* Wt, const float* rsx, u16* Hff, int mt, int nt, char* smem) {
  TILE_IDS
  f32x4 acc[4][4];
  ZERO_ACC(acc)
  gemm_main<4>(xb, 1024, Wt, 1024, 1024, mt * 128, nt * 128, acc, smem);
#pragma unroll
  for (int m = 0; m < 4; ++m)
#pragma unroll
    for (int j = 0; j < 4; ++j) {
      const int row = mt * 128 + wr * 64 + m * 16 + fq * 4 + j;
      const float r = rsx[row];
#pragma unroll
      for (int n = 0; n < 2; ++n) {
        const float g = acc[m][n][j] * r, u = acc[m][n + 2][j] * r;
        const float v = g * sigm(g) * u;
        Hff[(size_t)row * DFF + nt * 64 + wc * 32 + n * 16 + fr] = f2bf(v);
      }
    }
}

__device__ __forceinline__ bool tile_map(int i, int MT, int NT, int& mt, int& nt) {
  const int T = MT * NT, chunk = (T + 7) >> 3;
  const int x = i & 7, q = i >> 3;
  if (q >= chunk) return false;
  const int t = x * chunk + q;
  if (t >= T) return false;
  const int full = NT >> 3, pb = MT * 8;
  const int np = t / pb;
  if (np < full) { const int rem = t - np * pb; mt = rem >> 3; nt = np * 8 + (rem & 7); }
  else { const int wl = NT & 7; const int rem = t - full * pb; mt = rem / wl; nt = full * 8 + rem % wl; }
  return true;
}
#define FOR_TILES(MT, NT) \
  for (int i_ = bid, mt, nt; i_ < 8 * (((MT) * (NT) + 7) >> 3); i_ += nb) if (tile_map(i_, (MT), (NT), mt, nt))

#define GLDS(gp, lp) __builtin_amdgcn_global_load_lds((const unsigned*)(gp), (LAS unsigned*)(lp), 16, 0, 0)
__device__ __forceinline__ void big_issue(const u16* ag, const u16* bg, size_t astep, size_t bstep, char* dst) {
#pragma unroll
  for (int i = 0; i < 2; ++i) GLDS(ag + i * astep, dst + i * 4096);
#pragma unroll
  for (int i = 0; i < 4; ++i) GLDS(bg + i * bstep, dst + 8192 + i * 4096);
}
#undef GLDS

__device__ __forceinline__ bool next_tile(int& i, int nb, int bound, int MT, int NT, int& mt, int& nt) {
  while (i < bound) {
    if (tile_map(i, MT, NT, mt, nt)) return true;
    i += nb;
  }
  return false;
}

template <class Epi>
__device__ __forceinline__ void big_gemm_phase(const u16* __restrict__ A, int lda, const u16* __restrict__ Bt, int ldb,
                                               int K, int MT, int NT, char* smem, const float* __restrict__ rowscale, Epi epi) {
  const int tid = otid(), lane = tid & 63, wid = tid >> 6, wr = wid >> 1, wc = wid & 1;
  const int fr = lane & 15, fq = lane >> 4;
  const int l2 = lane ^ ((lane >> 5) << 1);
  const int Rl = wid * 16 + (l2 >> 2), Cl = (l2 & 3) * 8;
  const size_t astep = (size_t)64 * lda, bstep = (size_t)64 * ldb;
  const int rbase = (fr * 64 + fq * 16) ^ (((fr >> 3) & 1) << 5);
  const unsigned sbase = lds_addr(smem);
  const unsigned aoff = rbase + wr * 4096, boff = 8192 + rbase + wc * 8192;
  char* dst = smem + tid * 16;
  const int nb = gridDim.x, bound = 8 * ((MT * NT + 7) >> 3), nk = K >> 5;
  int i = blockIdx.x, mt, nt;
  bool have = next_tile(i, nb, bound, MT, NT, mt, nt);
  if (!have) return;
  const u16* ag = A + (size_t)(mt * 128 + Rl) * lda + Cl;
  const u16* bg = Bt + (size_t)(nt * 256 + Rl) * ldb + Cl;
  __syncthreads();
  big_issue(ag, bg, astep, bstep, dst);
  while (have) {
    f32x4 acc[4][8];
#pragma unroll
    for (int m = 0; m < 4; ++m)
#pragma unroll
      for (int n = 0; n < 8; ++n) acc[m][n] = f32x4{0.f, 0.f, 0.f, 0.f};
    float rs[4];
#pragma unroll
    for (int m = 0; m < 4; ++m) rs[m] = rowscale[mt * 128 + wr * 64 + m * 16 + fr];
    asm volatile("s_waitcnt vmcnt(0)" ::: "memory");
    __syncthreads();
    for (int kt = 0; kt < nk; ++kt) {
      const int cur = kt & 1;
      if (kt + 1 < nk) big_issue(ag + (kt + 1) * 32, bg + (kt + 1) * 32, astep, bstep, dst + (cur ^ 1) * 24576);
      bf16x8 af[4], bfv[8];
      {
        const unsigned aaddr = sbase + cur * 24576 + aoff, baddr = sbase + cur * 24576 + boff;
        DSR(af[0], aaddr, 0); DSR(af[1], aaddr, 1024); DSR(af[2], aaddr, 2048); DSR(af[3], aaddr, 3072);
        DSR(bfv[0], baddr, 0); DSR(bfv[1], baddr, 1024); DSR(bfv[2], baddr, 2048); DSR(bfv[3], baddr, 3072);
        DSR(bfv[4], baddr, 4096); DSR(bfv[5], baddr, 5120); DSR(bfv[6], baddr, 6144); DSR(bfv[7], baddr, 7168);
        asm volatile("s_waitcnt lgkmcnt(0)"
                     : "+v"(af[0]), "+v"(af[1]), "+v"(af[2]), "+v"(af[3]), "+v"(bfv[0]), "+v"(bfv[1]), "+v"(bfv[2]),
                       "+v"(bfv[3]), "+v"(bfv[4]), "+v"(bfv[5]), "+v"(bfv[6]), "+v"(bfv[7]));
      }
#pragma unroll
      for (int m = 0; m < 4; ++m)
#pragma unroll
        for (int n = 0; n < 8; ++n) acc[m][n] = MFMA16(bfv[n], af[m], acc[m][n]);
      __builtin_amdgcn_sched_barrier(0);
      asm volatile("s_waitcnt vmcnt(0)" ::: "memory");
      __syncthreads();
    }
    const int cmt = mt, cnt = nt;
    i += nb;
    have = next_tile(i, nb, bound, MT, NT, mt, nt);
    if (have) {
      ag = A + (size_t)(mt * 128 + Rl) * lda + Cl;
      bg = Bt + (size_t)(nt * 256 + Rl) * ldb + Cl;
      big_issue(ag, bg, astep, bstep, dst);
    }
    epi(acc, rs, cmt, cnt, wr, wc, fr, fq, smem + 24576);
  }
}

#define ZERO_ACC8(acc)                                 \
  _Pragma("unroll") for (int m_ = 0; m_ < 4; ++m_)     \
  _Pragma("unroll") for (int n_ = 0; n_ < 8; ++n_) acc[m_][n_] = f32x4{0.f, 0.f, 0.f, 0.f};

__device__ void ffn_up_phase(const u16* xb, const u16* Wt, const float* rsx, u16* Hff, char* smem) {
  big_gemm_phase(xb, 1024, Wt, 1024, 1024, 129, 22, smem, rsx,
                 [&](f32x4 (&acc)[4][8], const float (&rs)[4], int mt, int nt, int wr, int wc, int fr, int fq, char* stg) {
#pragma unroll
                   for (int m = 0; m < 4; ++m) {
                     const int lr = wr * 64 + m * 16 + fr;
                     const float r = rs[m];
                     char* sp = stg + lr * 272 + (wc * 64 + fq * 4) * 2;
#pragma unroll
                     for (int n = 0; n < 4; ++n) {
                       float v[4];
#pragma unroll
                       for (int jj = 0; jj < 4; ++jj) {
                         const float g = acc[m][n][jj] * r, u = acc[m][n + 4][jj] * r;
                         v[jj] = g * sigm(g) * u;
                       }
                       *(u32x2*)(sp + n * 32) = pack4(v[0], v[1], v[2], v[3]);
                     }
                   }
                   __syncthreads();
                   const int tid = otid();
#pragma unroll
                   for (int it = 0; it < 8; ++it) {
                     const int ch = tid + 256 * it, lr = ch >> 4, c16 = ch & 15;
                     const u32x4 v = *(const u32x4*)(stg + lr * 272 + c16 * 16);
                     *(u32x4*)(Hff + (size_t)(mt * 128 + lr) * DFF + nt * 128 + c16 * 8) = v;
                   }
                 });
}

__device__ void win_phase(const u16* xb, const u16* Wt, const float* rsx, u16* h, char* smem) {
  big_gemm_phase(xb, 1024, Wt, 1024, 1024, 129, 26, smem, rsx,
                 [&](f32x4 (&acc)[4][8], const float (&rs)[4], int mt, int nt, int wr, int wc, int fr, int fq, char* stg) {
                   const int tid = otid();
#pragma unroll
                   for (int ps = 0; ps < 2; ++ps) {
                     if (ps) __syncthreads();
#pragma unroll
                     for (int m = 0; m < 4; ++m) {
                       const int lr = wr * 64 + m * 16 + fr;
                       const float r = rs[m];
                       char* sp = stg + lr * 272 + (wc * 64 + fq * 4) * 2;
#pragma unroll
                       for (int n = 0; n < 4; ++n) {
                         const int cb = nt * 256 + wc * 128 + (ps * 4 + n) * 16;
                         float v[4];
#pragma unroll
                         for (int jj = 0; jj < 4; ++jj) {
                           v[jj] = acc[m][ps * 4 + n][jj] * r;
                           if (cb >= C_GATE) v[jj] = sigm(v[jj]);
                         }
                         *(u32x2*)(sp + n * 32) = pack4(v[0], v[1], v[2], v[3]);
                       }
                     }
                     __syncthreads();
#pragma unroll
                     for (int it = 0; it < 8; ++it) {
                       const int ch = tid + 256 * it, lr = ch >> 4, c16 = ch & 15;
                       const u32x4 v = *(const u32x4*)(stg + lr * 272 + c16 * 16);
                       const int c = c16 * 8;
                       *(u32x4*)(h + (size_t)(mt * 128 + lr) * HLD + nt * 256 + (c >> 6) * 128 + ps * 64 + (c & 63)) = v;
                     }
                   }
                 });
}

struct F32Item { int mt, nt, k0, kc; bool atomic; };
__device__ __forceinline__ bool f32_item(int i, int KS, int K, F32Item& it) {
  const int bound = 1024;
  if (i >= bound + 8 * KS) return false;
  if (i < bound) {
    tile_map(i, 128, 8, it.mt, it.nt);
    it.k0 = 0; it.kc = K; it.atomic = false;
  } else {
    const int u = i - bound, kcs = K / KS;
    it.mt = 128; it.nt = u & 7; it.k0 = (u >> 3) * kcs; it.kc = kcs; it.atomic = true;
  }
  return true;
}
__device__ void gemm_f32_phase(const u16* A, int lda, int K, const u16* Wt, float* y, int KS, char* smem) {
  TILE_IDS
  const int nb = gridDim.x;
  int i = blockIdx.x;
  F32Item cur, nxt;
  bool have = f32_item(i, KS, K, cur);
  if (!have) return;
  __syncthreads();
  gemm_first<4>(A + cur.k0, lda, Wt + cur.k0, K, cur.mt * 128, cur.nt * 128, smem);
  while (have) {
    f32x4 acc[4][4];
    ZERO_ACC(acc)
    gemm_main<4>(A + cur.k0, lda, Wt + cur.k0, K, cur.kc, cur.mt * 128, cur.nt * 128, acc, smem, true);
    i += nb;
    const bool hn = f32_item(i, KS, K, nxt);
    if (hn) gemm_first<4>(A + nxt.k0, lda, Wt + nxt.k0, K, nxt.mt * 128, nxt.nt * 128, smem);
#pragma unroll
    for (int m = 0; m < 4; ++m)
#pragma unroll
      for (int j = 0; j < 4; ++j) {
        const int row = cur.mt * 128 + wr * 64 + m * 16 + fq * 4 + j;
        float* yp = y + (size_t)row * 1024 + cur.nt * 128 + wc * 64 + fr;
        if (cur.atomic) {
#pragma unroll
          for (int n = 0; n < 4; ++n)
            (void)__hip_atomic_fetch_add(yp + n * 16, acc[m][n][j], __ATOMIC_RELAXED, __HIP_MEMORY_SCOPE_AGENT);
        } else {
#pragma unroll
          for (int n = 0; n < 4; ++n) yp[n * 16] = acc[m][n][j];
        }
      }
    cur = nxt;
    have = hn;
  }
}

__device__ void zero_y_sample(float* y) {
  for (int i = blockIdx.x * 256 + otid(); i < 128 * 1024; i += gridDim.x * 256) y[(size_t)MPR * 1024 + i] = 0.f;
}

__device__ void win_tile(const u16* xb, const u16* Wt, const float* rsx, u16* h, int mt, int nt, char* smem) {
  TILE_IDS
  f32x4 acc[4][4];
  ZERO_ACC(acc)
  gemm_main<4>(xb, 1024, Wt, 1024, 1024, mt * 128, nt * 128, acc, smem);
#pragma unroll
  for (int m = 0; m < 4; ++m)
#pragma unroll
    for (int j = 0; j < 4; ++j) {
      const int row = mt * 128 + wr * 64 + m * 16 + fq * 4 + j;
      const float r = rsx[row];
#pragma unroll
      for (int n = 0; n < 4; ++n) {
        const int cb = nt * 128 + wc * 64 + n * 16;
        float v = acc[m][n][j] * r;
        if (cb >= C_GATE) v = sigm(v);
        h[(size_t)row * HLD + cb + fr] = f2bf(v);
      }
    }
}

__device__ void q_tile(const u16* h, const u16* Wt, const float* rsq, const f32x2* ropeT, u16* q, int mt, int nt,
                       char* smem) {
  TILE_IDS
  f32x4 acc[4][4];
  ZERO_ACC(acc)
  gemm_main<4>(h + C_CQ, HLD, Wt, 384, 384, mt * 128, nt * 128, acc, smem);
  const float QS = 0.10206207261596577f * 1.4426950408889634f;
  const int s0 = (nt * 128 + wc * 64) >> 4;
#pragma unroll
  for (int m = 0; m < 4; ++m)
#pragma unroll
    for (int j = 0; j < 4; ++j) {
      const int row = mt * 128 + wr * 64 + m * 16 + fq * 4 + j;
      const float r = rsq[row] * QS;
      float v[4];
#pragma unroll
      for (int n = 0; n < 4; ++n) v[n] = acc[m][n][j] * r;
      const int pos = row < MPR ? (row & 2047) : 2048 + ((row - MPR) & 15);
      const f32x2 cs = ropeT[pos * 16 + fr];
#pragma unroll
      for (int n = 0; n < 4; n += 2) {
        if (((s0 + n) % 6) == 4) {
          const float x1 = v[n], x2 = v[n + 1];
          v[n] = x1 * cs.x - x2 * cs.y;
          v[n + 1] = x2 * cs.x + x1 * cs.y;
        }
      }
#pragma unroll
      for (int n = 0; n < 4; ++n) q[(size_t)row * 768 + nt * 128 + wc * 64 + n * 16 + fr] = f2bf(v[n]);
    }
}

__device__ void kv_tile(const u16* lat, const u16* Wt, u16* Kn, u16* Vtp, u16* Vts, int mt, int nt, bool pre, bool hn,
                        int mt2, int nt2, char* smem) {
  TILE_IDS
  f32x4 acc[4][4];
  ZERO_ACC(acc)
  if (!pre) { __syncthreads(); gemm_first<4>(lat, 256, Wt, 256, mt * 128, nt * 128, smem); }
  gemm_main<4>(lat, 256, Wt, 256, 256, mt * 128, nt * 128, acc, smem, true);
  if (hn) gemm_first<4>(lat, 256, Wt, 256, mt2 * 128, nt2 * 128, smem);
  const int hh = nt;
  if (wc == 0) {
#pragma unroll
    for (int m = 0; m < 4; ++m)
#pragma unroll
      for (int j = 0; j < 4; ++j) {
        const int row = mt * 128 + wr * 64 + m * 16 + fq * 4 + j;
#pragma unroll
        for (int n = 0; n < 4; ++n) Kn[(size_t)row * 512 + hh * 64 + n * 16 + fr] = f2bf(acc[m][n][j]);
      }
  } else {
#pragma unroll
    for (int m = 0; m < 4; ++m) {
      const int row = mt * 128 + wr * 64 + m * 16 + fq * 4;
      u16* base;
      size_t stride;
      int key;
      if (row < MPR) {
        const int b = row >> 11;
        key = row & 2047;
        base = Vtp + (size_t)(b * 8 + hh) * 64 * 2048;
        stride = 2048;
      } else {
        const int r2 = row - MPR;
        const int b = r2 / SKEYS;
        key = r2 - b * SKEYS;
        base = Vts + (size_t)(b * 8 + hh) * 64 * VSTR_S;
        stride = VSTR_S;
      }
#pragma unroll
      for (int n = 0; n < 4; ++n) {
        const int dim = n * 16 + fr;
        *(u32x2*)(base + (size_t)dim * stride + key) = pack4(acc[m][n][0], acc[m][n][1], acc[m][n][2], acc[m][n][3]);
      }
    }
  }
}

__device__ void merge_tile(const u16* abuf, const u16* yb, const u16* yc, const u16* yd, const u16* wa, const u16* wb,
                           const u16* wcc, const u16* wd, const u16* h, u16* mg, int mt, int nt, bool pre, bool hn, int mt2,
                           int nt2, char* smem) {
  TILE_IDS
  f32x4 tot[4][2];
#pragma unroll
  for (int m = 0; m < 4; ++m)
#pragma unroll
    for (int n = 0; n < 2; ++n) tot[m][n] = f32x4{0.f, 0.f, 0.f, 0.f};
  for (int b = 0; b < 4; ++b) {
    f32x4 acc[4][2];
#pragma unroll
    for (int m = 0; m < 4; ++m)
#pragma unroll
      for (int n = 0; n < 2; ++n) acc[m][n] = f32x4{0.f, 0.f, 0.f, 0.f};
    const u16* A = b == 0 ? abuf : (b == 1 ? yb : (b == 2 ? yc : yd));
    const u16* W = b == 0 ? wa : (b == 1 ? wb : (b == 2 ? wcc : wd));
    const int K = b == 0 ? 512 : 256;
    if (b == 0 && !pre) { __syncthreads(); gemm_first<2>(A, K, W, K, mt * 128, nt * 64, smem); }
    u16 gv[4][4][2];
#pragma unroll
    for (int m = 0; m < 4; ++m)
#pragma unroll
      for (int j = 0; j < 4; ++j) {
        const int row = mt * 128 + wr * 64 + m * 16 + fq * 4 + j;
        const u16* gp = h + (size_t)row * HLD + C_GATE + b * 1024 + nt * 64 + wc * 32 + fr;
        gv[m][j][0] = gp[0]; gv[m][j][1] = gp[16];
      }
    gemm_main<2>(A, K, W, K, K, mt * 128, nt * 64, acc, smem, true);
    if (b < 3) {
      const u16* A2 = b == 0 ? yb : (b == 1 ? yc : yd);
      const u16* W2 = b == 0 ? wb : (b == 1 ? wcc : wd);
      gemm_first<2>(A2, 256, W2, 256, mt * 128, nt * 64, smem);
    }
#pragma unroll
    for (int m = 0; m < 4; ++m)
#pragma unroll
      for (int j = 0; j < 4; ++j) {
#pragma unroll
        for (int n = 0; n < 2; ++n) tot[m][n][j] += bf2f(gv[m][j][n]) * acc[m][n][j];
      }
  }
  if (hn) gemm_first<2>(abuf, 512, wa, 512, mt2 * 128, nt2 * 64, smem);
#pragma unroll
  for (int m = 0; m < 4; ++m)
#pragma unroll
    for (int j = 0; j < 4; ++j) {
      const int row = mt * 128 + wr * 64 + m * 16 + fq * 4 + j;
#pragma unroll
      for (int n = 0; n < 2; ++n) mg[(size_t)row * 1024 + nt * 64 + wc * 32 + n * 16 + fr] = f2bf(tot[m][n][j]);
    }
}

__device__ __forceinline__ void conv_load(const float* __restrict__ src, int ld, int nvalid, int mode,
                                          const float* __restrict__ scale, int n0, int k0, float (&v)[16]) {
  const int tid = otid();
  const int nn = tid & 63, kk0 = tid >> 6;
  const int n = n0 + nn;
  int sc = n;
  if (mode == 1) {
    const int G = n >> 4, T = G >> 4, w = (G >> 3) & 1, q = G & 7;
    sc = (q >> 2) * DFF + T * 128 + w * 64 + (q & 3) * 16 + (n & 15);
  }
  const bool valid = n < nvalid;
#pragma unroll
  for (int i = 0; i < 16; ++i) {
    const int kk = kk0 + 4 * i;
    float x = 0.f;
    if (valid) {
      x = src[(size_t)(k0 + kk) * ld + sc];
      if (scale) x *= scale[k0 + kk];
    }
    v[i] = x;
  }
}
__device__ __forceinline__ void conv_commit(const float (&v)[16], u16* __restrict__ dst, int K, int n0, int k0,
                                            char* smem) {
  float* sm = (float*)smem;
  const int tid = otid();
  __syncthreads();
  {
    const int nn = tid & 63, kk0 = tid >> 6;
#pragma unroll
    for (int i = 0; i < 16; ++i) sm[(kk0 + 4 * i) * 65 + nn] = v[i];
  }
  __syncthreads();
  {
    const int c8 = tid & 7;
#pragma unroll
    for (int it = 0; it < 2; ++it) {
      const int nn = (tid >> 3) + 32 * it;
      float f[8];
#pragma unroll
      for (int e = 0; e < 8; ++e) f[e] = sm[(c8 * 8 + e) * 65 + nn];
      u32x4 o;
      o.x = pk2(f[0], f[1]); o.y = pk2(f[2], f[3]); o.z = pk2(f[4], f[5]); o.w = pk2(f[6], f[7]);
      *(u32x4*)(dst + (size_t)(n0 + nn) * K + k0 + c8 * 8) = o;
    }
  }
}

__device__ void convert_layer(const Params& p, int l, char* smem) {
  char* ws = p.ws;
  const int NJ = 12;
  const int jt[NJ + 1] = {0, 1408, 2112, 3776, 3848, 3912, 4040, 4104, 4168, 4232, 4488, 5896, 6600};
  bool havePrev = false;
  float pv[16];
  u16* pdst = nullptr;
  int pK = 0, pn0 = 0, pk0 = 0;
  for (int it = blockIdx.x;; it += gridDim.x) {
    const bool valid = it < 6600;
    float nv[16];
    u16* ndst_p = nullptr;
    int nK = 0, nn0 = 0, nk0 = 0;
    if (valid) {
      int j = 0, jbase = 0;
#pragma unroll
      for (int q = 1; q < NJ; ++q)
        if (it >= jt[q]) { j = q; jbase = jt[q]; }
      const int loc = it - jbase;
      const float* src; int ld, K, nvalid, mode = 0, ndst; u16* dst; const float* scale = nullptr;
      switch (j) {
        case 0: src = p.in[8] + (size_t)l * 1024 * 5632; ld = 5632; K = 1024; ndst = 5632; nvalid = 5632; mode = 1;
                dst = (u16*)(ws + W_GU1); scale = p.in[6] + l * 1024; break;
        case 1: src = p.in[9] + (size_t)l * 2816 * 1024; ld = 1024; K = 2816; ndst = 1024; nvalid = 1024;
                dst = (u16*)(ws + W_D1); break;
        case 2: src = p.in[12] + (size_t)l * 1024 * DIN; ld = DIN; K = 1024; ndst = HLD; nvalid = DIN;
                dst = (u16*)(ws + W_IN); scale = p.in[10] + l * 1024; break;
        case 3: src = p.in[14] + (size_t)l * 384 * 768; ld = 768; K = 384; ndst = 768; nvalid = 768;
                dst = (u16*)(ws + W_UQ); scale = p.in[13] + l * 384; break;
        case 4: src = p.in[16] + (size_t)l * 256 * 1024; ld = 1024; K = 256; ndst = 1024; nvalid = 1024;
                dst = (u16*)(ws + W_UKV); break;
        case 5: src = p.in[26] + (size_t)l * 512 * 1024; ld = 1024; K = 512; ndst = 1024; nvalid = 1024;
                dst = (u16*)(ws + W_BRA); break;
        case 6: src = p.in[27] + (size_t)l * 256 * 1024; ld = 1024; K = 256; ndst = 1024; nvalid = 1024;
                dst = (u16*)(ws + W_BRB); break;
        case 7: src = p.in[28] + (size_t)l * 256 * 1024; ld = 1024; K = 256; ndst = 1024; nvalid = 1024;
                dst = (u16*)(ws + W_BRC); break;
        case 8: src = p.in[29] + (size_t)l * 256 * 1024; ld = 1024; K = 256; ndst = 1024; nvalid = 1024;
                dst = (u16*)(ws + W_BRD); break;
        case 9: src = p.in[30] + (size_t)l * 1024 * 1024; ld = 1024; K = 1024; ndst = 1024; nvalid = 1024;
                dst = (u16*)(ws + W_O); break;
        case 10: src = p.in[33] + (size_t)l * 1024 * 5632; ld = 5632; K = 1024; ndst = 5632; nvalid = 5632; mode = 1;
                dst = (u16*)(ws + W_GU2); scale = p.in[31] + l * 1024; break;
        default: src = p.in[34] + (size_t)l * 2816 * 1024; ld = 1024; K = 2816; ndst = 1024; nvalid = 1024;
                dst = (u16*)(ws + W_D2); break;
      }
      const int ntn = ndst >> 6;
      nn0 = (loc % ntn) * 64; nk0 = (loc / ntn) * 64; nK = K; ndst_p = dst;
      conv_load(src, ld, nvalid, mode, scale, nn0, nk0, nv);
    }
    if (havePrev) conv_commit(pv, pdst, pK, pn0, pk0, smem);
    if (!valid) break;
#pragma unroll
    for (int q = 0; q < 16; ++q) pv[q] = nv[q];
    pdst = ndst_p; pK = nK; pn0 = nn0; pk0 = nk0; havePrev = true;
  }
  for (int it = 6600 + blockIdx.x; it < 6600 + 288; it += gridDim.x) {
    {
      const int ci = it - 6600;
      const int tid = otid();
      if (ci < 256) {
        const float* src = p.in[2] + (size_t)l * 8 * 2048 * 256;
        u16* dst = (u16*)(ws + B_LAT) + (size_t)MPR * 256;
#pragma unroll 2
        for (int i = 0; i < 8; ++i) {
          const size_t ch = (size_t)ci * 2048 + i * 256 + tid;
          const size_t e = ch * 8;
          const int b = (int)(e / (2048 * 256));
          const size_t within = e - (size_t)b * 2048 * 256;
          const f32x4 v0 = *(const f32x4*)(src + e), v1 = *(const f32x4*)(src + e + 4);
          u32x4 o;
          o.x = pk2(v0.x, v0.y); o.y = pk2(v0.z, v0.w); o.z = pk2(v1.x, v1.y); o.w = pk2(v1.z, v1.w);
          *(u32x4*)(dst + (size_t)b * SKEYS * 256 + within) = o;
        }
      } else {
        const int c2 = ci - 256;
        const float* src = p.in[3] + (size_t)l * 8 * 2048 * 32;
        u16* dst = (u16*)(ws + B_KR) + (size_t)MPR * 32;
#pragma unroll 2
        for (int i = 0; i < 8; ++i) {
          const size_t ch = (size_t)c2 * 2048 + i * 256 + tid;
          const size_t e = ch * 8;
          const int b = (int)(e / (2048 * 32));
          const size_t within = e - (size_t)b * 2048 * 32;
          const f32x4 v0 = *(const f32x4*)(src + e), v1 = *(const f32x4*)(src + e + 4);
          u32x4 o;
          o.x = pk2(v0.x, v0.y); o.y = pk2(v0.z, v0.w); o.z = pk2(v1.x, v1.y); o.w = pk2(v1.z, v1.w);
          *(u32x4*)(dst + (size_t)b * SKEYS * 32 + within) = o;
        }
      }
    }
  }
}

__device__ void row_update(const Params& p, int mode, float alpha, const float* g) {
  const int lane = otid() & 63, wid = otid() >> 6;
  float* x = p.out;
  const float* y = (const float*)(p.ws + B_Y);
  u16* xb = (u16*)(p.ws + B_XB);
  float* rsx = (float*)(p.ws + B_RSX);
  const int stride = gridDim.x * 4;
  int row = blockIdx.x * 4 + wid;
  if (row >= MROWS) return;
  f32x4 xv[4], yv[4], gv[4];
  if (mode == 0) {
#pragma unroll
    for (int i = 0; i < 4; ++i) { yv[i] = f32x4{0.f, 0.f, 0.f, 0.f}; gv[i] = f32x4{0.f, 0.f, 0.f, 0.f}; }
  } else {
#pragma unroll
    for (int i = 0; i < 4; ++i) gv[i] = *(const f32x4*)(g + i * 256 + lane * 4);
  }
  auto load_row = [&](int r, f32x4 (&xr)[4], f32x4 (&yr)[4]) {
    if (mode == 0) {
      const float* src = r < MPR ? p.in[0] + (size_t)r * 1024 : p.in[1] + (size_t)(r - MPR) * 1024;
#pragma unroll
      for (int i = 0; i < 4; ++i) xr[i] = *(const f32x4*)(src + i * 256 + lane * 4);
    } else {
#pragma unroll
      for (int i = 0; i < 4; ++i) {
        yr[i] = *(const f32x4*)(y + (size_t)r * 1024 + i * 256 + lane * 4);
        xr[i] = *(const f32x4*)(x + (size_t)r * 1024 + i * 256 + lane * 4);
      }
    }
  };
  load_row(row, xv, yv);
  for (;;) {
    const int nrow = row + stride;
    const bool hn = nrow < MROWS;
    f32x4 xn[4], yn[4];
#pragma unroll
    for (int i = 0; i < 4; ++i) { xn[i] = f32x4{0.f, 0.f, 0.f, 0.f}; yn[i] = f32x4{0.f, 0.f, 0.f, 0.f}; }
    if (hn) load_row(nrow, xn, yn);
    if (mode != 0) {
      float ss = 0.f;
#pragma unroll
      for (int i = 0; i < 4; ++i)
        ss += yv[i].x * yv[i].x + yv[i].y * yv[i].y + yv[i].z * yv[i].z + yv[i].w * yv[i].w;
      ss = wave_sum(ss);
      const float r = rsqrtf(ss * (1.f / 1024.f) + EPSV) * alpha;
#pragma unroll
      for (int i = 0; i < 4; ++i) {
        xv[i].x += yv[i].x * r * gv[i].x; xv[i].y += yv[i].y * r * gv[i].y;
        xv[i].z += yv[i].z * r * gv[i].z; xv[i].w += yv[i].w * r * gv[i].w;
      }
    }
    float s2 = 0.f;
#pragma unroll
    for (int i = 0; i < 4; ++i) {
      s2 += xv[i].x * xv[i].x + xv[i].y * xv[i].y + xv[i].z * xv[i].z + xv[i].w * xv[i].w;
      *(f32x4*)(x + (size_t)row * 1024 + i * 256 + lane * 4) = xv[i];
      *(u32x2*)(xb + (size_t)row * 1024 + i * 256 + lane * 4) = pack4(xv[i].x, xv[i].y, xv[i].z, xv[i].w);
    }
    s2 = wave_sum(s2);
    if (lane == 0) rsx[row] = rsqrtf(s2 * (1.f / 1024.f) + EPSV);
    if (!hn) break;
    row = nrow;
#pragma unroll
    for (int i = 0; i < 4; ++i) { xv[i] = xn[i]; yv[i] = yn[i]; }
  }
}

__device__ void row_prep(const Params& p, int l) {
  const int lane = otid() & 63, wid = otid() >> 6;
  char* ws = p.ws;
  u16* h = (u16*)(ws + B_BIG);
  float* rsq = (float*)(ws + B_RSQ);
  const f32x2* ropeT = (const f32x2*)(ws + B_ROPE);
  u16* lat = (u16*)(ws + B_LAT);
  u16* kra = (u16*)(ws + B_KR);
  float* out = p.out;
  for (int row = blockIdx.x * 4 + wid; row < MROWS; row += gridDim.x * 4) {
    u16* hr = h + (size_t)row * HLD;
    const bool smp = row >= MPR;
    int b, t, pos;
    size_t latrow;
    if (!smp) { b = row >> 11; t = row & 2047; pos = t; latrow = row; }
    else { const int r2 = row - MPR; b = r2 >> 4; t = r2 & 15; pos = 2048 + t; latrow = (size_t)MPR + (size_t)b * SKEYS + 2048 + t; }
    const int lb = l * 8 + b;
    u32x4 ld_cq = u32x4{0u, 0u, 0u, 0u};
    if (lane < 48) ld_cq = *(const u32x4*)(hr + C_CQ + lane * 8);
    const u32x2 ld_kv = *(const u32x2*)(hr + C_KV + lane * 4);
    u16 ld_k1 = 0, ld_k2 = 0;
    if (lane < 16) { ld_k1 = hr[C_KR + lane]; ld_k2 = hr[C_KR + 16 + lane]; }
    const u32x2 ld_ga = *(const u32x2*)(hr + C_GA + lane * 4);
    const u32x2 ld_gg = *(const u32x2*)(hr + C_GG + lane * 4);
    const u32x2 ld_v = *(const u32x2*)(hr + C_V + lane * 4);
    const u32x2 ld_cg = *(const u32x2*)(hr + C_CG + lane * 4);
    const u32x2 ld_hd = *(const u32x2*)(hr + C_HD + lane * 4);
    {
      float ss = 0.f;
      if (lane < 48) {
        const u32x4 v = ld_cq;
        float f[4];
        unpack4(u32x2{v.x, v.y}, f); ss += f[0] * f[0] + f[1] * f[1] + f[2] * f[2] + f[3] * f[3];
        unpack4(u32x2{v.z, v.w}, f); ss += f[0] * f[0] + f[1] * f[1] + f[2] * f[2] + f[3] * f[3];
      }
      ss = wave_sum(ss);
      if (lane == 0) rsq[row] = rsqrtf(ss * (1.f / 384.f) + EPSV);
    }
    {
      float f[4];
      unpack4(ld_kv, f);
      float ss = wave_sum(f[0] * f[0] + f[1] * f[1] + f[2] * f[2] + f[3] * f[3]);
      const float r = rsqrtf(ss * (1.f / 256.f) + EPSV);
      const f32x4 g = *(const f32x4*)(p.in[15] + l * 256 + lane * 4);
      f32x4 o;
      o.x = f[0] * r * g.x; o.y = f[1] * r * g.y; o.z = f[2] * r * g.z; o.w = f[3] * r * g.w;
      float* op = smp ? out + O_LATS + ((size_t)lb * 16 + t) * 256 : out + O_LATP + ((size_t)lb * 2048 + t) * 256;
      *(f32x4*)(op + lane * 4) = o;
      *(u32x2*)(lat + latrow * 256 + lane * 4) = pack4(o.x, o.y, o.z, o.w);
    }
    if (lane < 16) {
      const float x1 = bf2f(ld_k1), x2 = bf2f(ld_k2);
      const f32x2 cs = ropeT[pos * 16 + lane];
      const float o1 = x1 * cs.x - x2 * cs.y, o2 = x2 * cs.x + x1 * cs.y;
      float* op = smp ? out + O_KRS + ((size_t)lb * 16 + t) * 32 : out + O_KRP + ((size_t)lb * 2048 + t) * 32;
      op[lane] = o1; op[lane + 16] = o2;
      kra[latrow * 32 + lane] = f2bf(o1);
      kra[latrow * 32 + 16 + lane] = f2bf(o2);
    }
    {
      float a[4], gg[4];
      unpack4(ld_ga, a);
      unpack4(ld_gg, gg);
      f32x4 o;
      o.x = a[0] * sigm(gg[0]); o.y = a[1] * sigm(gg[1]); o.z = a[2] * sigm(gg[2]); o.w = a[3] * sigm(gg[3]);
      *(u32x2*)(hr + C_GA + lane * 4) = pack4(o.x, o.y, o.z, o.w);
      if (!smp) {
        if (t >= 2018) *(f32x4*)(out + O_CBP + ((size_t)lb * 30 + (t - 2018)) * 256 + lane * 4) = o;
      } else {
        *(f32x4*)(out + O_CBS + ((size_t)lb * 30 + 14 + t) * 256 + lane * 4) = o;
        if (t < 14)
          *(f32x4*)(out + O_CBS + ((size_t)lb * 30 + t) * 256 + lane * 4) =
              *(const f32x4*)(p.in[4] + ((size_t)lb * 30 + 16 + t) * 256 + lane * 4);
      }
    }
    {
      float f[4];
      unpack4(ld_v, f);
      const float mean = wave_sum(f[0] + f[1] + f[2] + f[3]) * (1.f / 256.f);
      const float d0 = f[0] - mean, d1 = f[1] - mean, d2 = f[2] - mean, d3 = f[3] - mean;
      const float var = wave_sum(d0 * d0 + d1 * d1 + d2 * d2 + d3 * d3) * (1.f / 256.f);
      const float r = rsqrtf(var + EPSV);
      const f32x4 g = *(const f32x4*)(p.in[21] + l * 256 + lane * 4);
      const f32x4 bb = *(const f32x4*)(p.in[22] + l * 256 + lane * 4);
      f32x4 o;
      o.x = d0 * r * g.x + bb.x; o.y = d1 * r * g.y + bb.y; o.z = d2 * r * g.z + bb.z; o.w = d3 * r * g.w + bb.w;
      *(u32x2*)(hr + C_V + lane * 4) = pack4(o.x, o.y, o.z, o.w);
      if (smp) *(f32x4*)(out + O_VS + ((size_t)lb * 16 + t) * 256 + lane * 4) = o;
    }
    {
      float c[4], hd[4];
      unpack4(ld_cg, c);
      unpack4(ld_hd, hd);
      f32x4 o;
      o.x = c[0] * hd[0]; o.y = c[1] * hd[1]; o.z = c[2] * hd[2]; o.w = c[3] * hd[3];
      *(u32x2*)(hr + C_CG + lane * 4) = pack4(o.x, o.y, o.z, o.w);
      if (!smp) {
        if (t >= 2046) *(f32x4*)(out + O_CDP + ((size_t)lb * 2 + (t - 2046)) * 256 + lane * 4) = o;
      } else {
        if (t >= 14) *(f32x4*)(out + O_CDS + ((size_t)lb * 2 + (t - 14)) * 256 + lane * 4) = o;
      }
    }
  }
}

__device__ void conv_item(const Params& p, int l, int item, char* smem) {
  const int tid = otid(), lane = tid & 63, wid = tid >> 6;
  char* ws = p.ws;
  const u16* h = (const u16*)(ws + B_BIG);
  u16* ybp = (u16*)(ws + B_YB);
  u16* ydp = (u16*)(ws + B_YD);
  u16* X = (u16*)smem;
  float* Wc = (float*)(smem + 31744);
  const bool smp = item >= 512;
  int b, t0;
  size_t R0;
  if (!smp) { b = item >> 6; t0 = (item & 63) * 32; R0 = (size_t)b * 2048; }
  else { b = item - 512; t0 = 0; R0 = (size_t)MPR + b * 16; }
  const int lb = l * 8 + b;
  __syncthreads();
  {
    u32x4 xv[8];
    f32x4 wv[8];
    const f32x4* wsrc = (const f32x4*)(p.in[17] + (size_t)l * 31 * 256);
#pragma unroll
    for (int it = 0; it < 8; ++it) {
      const int ch = tid + 256 * it;
      const int i = ch >> 5, c8 = ch & 31;
      const int tt = t0 - 30 + i;
      u32x4 v = u32x4{0u, 0u, 0u, 0u};
      if (ch < 62 * 32) {
        if (!smp) {
          if (tt >= 0) v = *(const u32x4*)(h + (R0 + tt) * HLD + C_GA + c8 * 8);
        } else {
          if (tt < 0) {
            const float* sp = p.in[4] + ((size_t)lb * 30 + (30 + tt)) * 256 + c8 * 8;
            const f32x4 v0 = *(const f32x4*)sp, v1 = *(const f32x4*)(sp + 4);
            v.x = pk2(v0.x, v0.y); v.y = pk2(v0.z, v0.w); v.z = pk2(v1.x, v1.y); v.w = pk2(v1.z, v1.w);
          } else if (tt < 16) {
            v = *(const u32x4*)(h + (R0 + tt) * HLD + C_GA + c8 * 8);
          }
        }
      }
      xv[it] = v;
      wv[it] = ch < 1984 ? wsrc[ch] : f32x4{0.f, 0.f, 0.f, 0.f};
    }
#pragma unroll
    for (int it = 0; it < 8; ++it) {
      const int ch = tid + 256 * it;
      if (ch < 62 * 32) {
        *(u32x4*)(X + (ch >> 5) * 256 + (ch & 31) * 8) = xv[it];
        ((f32x4*)Wc)[ch] = wv[it];
      }
    }
  }
  __syncthreads();
  if (!smp || wid < 2) {
    const int tr0 = wid * 8;
    float acc[8][4];
    {
      const f32x4 bi = *(const f32x4*)(p.in[18] + l * 256 + lane * 4);
#pragma unroll
      for (int r = 0; r < 8; ++r) { acc[r][0] = bi.x; acc[r][1] = bi.y; acc[r][2] = bi.z; acc[r][3] = bi.w; }
    }
    {
      const f32x4 dw0 = *(const f32x4*)(p.in[25] + (size_t)l * 768 + lane * 4);
      const f32x4 dw1 = *(const f32x4*)(p.in[25] + (size_t)l * 768 + 256 + lane * 4);
      const f32x4 dw2 = *(const f32x4*)(p.in[25] + (size_t)l * 768 + 512 + lane * 4);
      float xf[10][4];
      u32x2 bgv[8];
#pragma unroll
      for (int q = 0; q < 10; ++q) {
        const int tq = t0 + tr0 + q - 2;
        if (tq >= 0) {
          unpack4(*(const u32x2*)(h + (R0 + tq) * HLD + C_CG + lane * 4), xf[q]);
        } else if (smp) {
          const f32x4 sv = *(const f32x4*)(p.in[5] + ((size_t)lb * 2 + (2 + tq)) * 256 + lane * 4);
          xf[q][0] = sv.x; xf[q][1] = sv.y; xf[q][2] = sv.z; xf[q][3] = sv.w;
        } else {
          xf[q][0] = xf[q][1] = xf[q][2] = xf[q][3] = 0.f;
        }
      }
#pragma unroll
      for (int r = 0; r < 8; ++r) bgv[r] = *(const u32x2*)(h + (R0 + t0 + tr0 + r) * HLD + C_BG + lane * 4);
#pragma unroll
      for (int r = 0; r < 8; ++r) {
        float bg[4];
        unpack4(bgv[r], bg);
        const float z0 = bg[0] * (dw2.x * xf[r + 2][0] + dw1.x * xf[r + 1][0] + dw0.x * xf[r][0]);
        const float z1 = bg[1] * (dw2.y * xf[r + 2][1] + dw1.y * xf[r + 1][1] + dw0.y * xf[r][1]);
        const float z2 = bg[2] * (dw2.z * xf[r + 2][2] + dw1.z * xf[r + 1][2] + dw0.z * xf[r][2]);
        const float z3 = bg[3] * (dw2.w * xf[r + 2][3] + dw1.w * xf[r + 1][3] + dw0.w * xf[r][3]);
        *(u32x2*)(ydp + (R0 + t0 + tr0 + r) * 256 + lane * 4) = pack4(z0, z1, z2, z3);
      }
    }
    for (int k = 0; k < 31; ++k) {
      const f32x4 w4 = *(const f32x4*)(Wc + k * 256 + lane * 4);
#pragma unroll
      for (int r = 0; r < 8; ++r) {
        float xv[4];
        unpack4(*(const u32x2*)(X + (tr0 + r + k) * 256 + lane * 4), xv);
        acc[r][0] += w4.x * xv[0]; acc[r][1] += w4.y * xv[1]; acc[r][2] += w4.z * xv[2]; acc[r][3] += w4.w * xv[3];
      }
    }
    const f32x4 lg = *(const f32x4*)(p.in[19] + l * 256 + lane * 4);
    const f32x4 lbb = *(const f32x4*)(p.in[20] + l * 256 + lane * 4);
#pragma unroll
    for (int r = 0; r < 8; ++r) {
      const int t = t0 + tr0 + r;
      const size_t row = R0 + t;
      const float mean = wave_sum(acc[r][0] + acc[r][1] + acc[r][2] + acc[r][3]) * (1.f / 256.f);
      const float d0 = acc[r][0] - mean, d1 = acc[r][1] - mean, d2 = acc[r][2] - mean, d3 = acc[r][3] - mean;
      const float var = wave_sum(d0 * d0 + d1 * d1 + d2 * d2 + d3 * d3) * (1.f / 256.f);
      const float rs = rsqrtf(var + EPSV);
      float y0 = d0 * rs * lg.x + lbb.x, y1 = d1 * rs * lg.y + lbb.y, y2 = d2 * rs * lg.z + lbb.z,
            y3 = d3 * rs * lg.w + lbb.w;
      y0 *= sigm(y0); y1 *= sigm(y1); y2 *= sigm(y2); y3 *= sigm(y3);
      *(u32x2*)(ybp + row * 256 + lane * 4) = pack4(y0, y1, y2, y3);
    }
  }
}

__device__ void gmlp_item(const Params& p, int l, int item, char* smem) {
  const int tid = otid(), lane = tid & 63, wid = tid >> 6, fr = lane & 15, fq = lane >> 4;
  char* ws = p.ws;
  const u16* h = (const u16*)(ws + B_BIG);
  u16* ycp = (u16*)(ws + B_YC);
  u16* vT = (u16*)smem;
  int b, g, nrows;
  size_t R0;
  if (item < 512) { b = item >> 6; const int n = (item >> 2) & 15; g = item & 3; R0 = (size_t)b * 2048 + n * 128; nrows = 128; }
  else { const int i2 = item - 512; b = i2 >> 2; g = i2 & 3; R0 = (size_t)MPR + b * 16; nrows = 16; }
  const float* Wg = p.in[23] + (size_t)(l * 4 + g) * 16384;
  const float* bs = p.in[24] + (size_t)(l * 4 + g) * 128;
  u32x4 fv[4];
#pragma unroll
  for (int it = 0; it < 4; ++it) {
    const int ch = tid + 256 * it, j = ch >> 3, c8 = ch & 7;
    fv[it] = u32x4{0u, 0u, 0u, 0u};
    if (j < nrows) fv[it] = *(const u32x4*)(h + (R0 + j) * HLD + C_V + g * 64 + c8 * 8);
  }
  f32x4 wq[2][4][2];
  float bsv[2][4];
  u16 uu[2][4][4];
#pragma unroll
  for (int mm = 0; mm < 2; ++mm) {
    const int m = wid * 2 + mm;
    const int kmax = (m * 16 < nrows) ? ((nrows == 16) ? 1 : (m < 4 ? 2 : 4)) : 0;
#pragma unroll
    for (int ks = 0; ks < 4; ++ks) {
      wq[mm][ks][0] = f32x4{0.f, 0.f, 0.f, 0.f};
      wq[mm][ks][1] = f32x4{0.f, 0.f, 0.f, 0.f};
      if (ks < kmax) {
        const float* wp = Wg + (size_t)(m * 16 + fr) * 128 + ks * 32 + fq * 8;
        wq[mm][ks][0] = *(const f32x4*)wp;
        wq[mm][ks][1] = *(const f32x4*)(wp + 4);
      }
    }
#pragma unroll
    for (int j = 0; j < 4; ++j) {
      const int i = m * 16 + fq * 4 + j;
      bsv[mm][j] = 0.f;
#pragma unroll
      for (int n = 0; n < 4; ++n) uu[mm][j][n] = 0;
      if (i < nrows) {
        bsv[mm][j] = bs[i];
#pragma unroll
        for (int n = 0; n < 4; ++n) uu[mm][j][n] = h[(R0 + i) * HLD + C_U + g * 64 + n * 16 + fr];
      }
    }
  }
  __syncthreads();
#pragma unroll
  for (int it = 0; it < 4; ++it) {
    const int ch = tid + 256 * it, j = ch >> 3, c8 = ch & 7;
    const u32x4 v = fv[it];
    u16* d = vT + (c8 * 8) * 136 + j;
    d[0 * 136] = (u16)(v.x & 0xffff); d[1 * 136] = (u16)(v.x >> 16);
    d[2 * 136] = (u16)(v.y & 0xffff); d[3 * 136] = (u16)(v.y >> 16);
    d[4 * 136] = (u16)(v.z & 0xffff); d[5 * 136] = (u16)(v.z >> 16);
    d[6 * 136] = (u16)(v.w & 0xffff); d[7 * 136] = (u16)(v.w >> 16);
  }
  __syncthreads();
  f32x4 acc[2][4];
#pragma unroll
  for (int mm = 0; mm < 2; ++mm)
#pragma unroll
    for (int n = 0; n < 4; ++n) acc[mm][n] = f32x4{0.f, 0.f, 0.f, 0.f};
#pragma unroll
  for (int mm = 0; mm < 2; ++mm) {
    const int m = wid * 2 + mm;
    if (m * 16 < nrows) {
      const int kmax = (nrows == 16) ? 1 : (m < 4 ? 2 : 4);
#pragma unroll
      for (int ks = 0; ks < 4; ++ks) {
        if (ks < kmax) {
          const f32x4 w0 = wq[mm][ks][0], w1 = wq[mm][ks][1];
          union { u32x4 u; bf16x8 v; } cv;
          cv.u.x = pk2(w0.x, w0.y); cv.u.y = pk2(w0.z, w0.w); cv.u.z = pk2(w1.x, w1.y); cv.u.w = pk2(w1.z, w1.w);
#pragma unroll
          for (int n = 0; n < 4; ++n) {
            const bf16x8 bv = *(const bf16x8*)(vT + (n * 16 + fr) * 136 + ks * 32 + fq * 8);
            acc[mm][n] = MFMA16(cv.v, bv, acc[mm][n]);
          }
        }
      }
    }
  }
#pragma unroll
  for (int mm = 0; mm < 2; ++mm) {
    const int m = wid * 2 + mm;
#pragma unroll
    for (int j = 0; j < 4; ++j) {
      const int i = m * 16 + fq * 4 + j;
      if (i < nrows) {
#pragma unroll
        for (int n = 0; n < 4; ++n) {
          const int c = g * 64 + n * 16 + fr;
          ycp[(R0 + i) * 256 + c] = f2bf(bf2f(uu[mm][j][n]) * (acc[mm][n][j] + bsv[mm][j]));
        }
      }
    }
  }
}

__device__ void attn_item(const Params& p, int idx, char* smem) {
  const int tid = otid(), lane = tid & 63, wid = tid >> 6, fr = lane & 15, fq = lane >> 4;
  char* ws = p.ws;
  const u16* qb = (const u16*)(ws + B_Q);
  const u16* Kn = (const u16*)(ws + B_KN);
  const u16* kra = (const u16*)(ws + B_KR);
  u16* ab = (u16*)(ws + B_A);
  int hh, ntiles, myt, nkeys, vstride;
  size_t qrow[2], krow0;
  const u16* Vp;
  const bool smp = idx < 64;
  if (smp) {
    const int b = idx >> 3; hh = idx & 7; ntiles = 33; myt = 33; nkeys = SKEYS; vstride = VSTR_S;
    qrow[0] = qrow[1] = (size_t)MPR + b * 16 + fr; krow0 = (size_t)MPR + (size_t)b * SKEYS;
    Vp = (const u16*)(ws + B_VTS) + (size_t)(b * 8 + hh) * 64 * VSTR_S;
  } else {
    const int i = idx - 64; const int pp = 15 - (i >> 6); const int b = (i & 63) >> 3; hh = i & 7;
    ntiles = 2 * pp + 2; myt = 2 * pp + 1 + (wid >> 1); nkeys = 2048; vstride = 2048;
    qrow[0] = (size_t)b * 2048 + pp * 128 + wid * 32 + fr; qrow[1] = qrow[0] + 16; krow0 = (size_t)b * 2048;
    Vp = (const u16*)(ws + B_VTP) + (size_t)(b * 8 + hh) * 64 * 2048;
  }
  const u16* Kp = Kn + krow0 * 512 + hh * 64;
  const u16* KRp = kra + krow0 * 32;
  bf16x8 qf[2][3];
#pragma unroll
  for (int qs = 0; qs < 2; ++qs)
#pragma unroll
    for (int ks = 0; ks < 3; ++ks) qf[qs][ks] = *(const bf16x8*)(qb + qrow[qs] * 768 + hh * 96 + ks * 32 + fq * 8);
  char* Ks = smem;
  char* Vs = smem + 26624;
  const u32x4 z4 = u32x4{0u, 0u, 0u, 0u};
  u32x4 rk[2], rr, rv[2];
#define ATT_LOAD(kt)                                                                                   \
  {                                                                                                    \
    _Pragma("unroll") for (int i = 0; i < 2; ++i) {                                                    \
      const int ch = tid + 256 * i; const int key = (kt) * 64 + (ch >> 3), c8 = ch & 7;                \
      rk[i] = key < nkeys ? *(const u32x4*)(Kp + (size_t)key * 512 + c8 * 8) : z4;                     \
      const int dim = ch >> 3; const int k0 = (kt) * 64 + c8 * 8;                                      \
      rv[i] = k0 < nkeys ? *(const u32x4*)(Vp + (size_t)dim * vstride + k0) : z4;                      \
    }                                                                                                  \
    { const int key = (kt) * 64 + (tid >> 2), c4 = tid & 3;                                            \
      rr = key < nkeys ? *(const u32x4*)(KRp + (size_t)key * 32 + c4 * 8) : z4; }                      \
  }
#define ATT_STORE(buf)                                                                                 \
  {                                                                                                    \
    _Pragma("unroll") for (int i = 0; i < 2; ++i) {                                                    \
      const int ch = tid + 256 * i;                                                                    \
      *(u32x4*)(Ks + (buf) * 13312 + (ch >> 3) * 208 + (ch & 7) * 16) = rk[i];                         \
      *(u32x4*)(Vs + (buf) * 9216 + (ch >> 3) * 144 + (ch & 7) * 16) = rv[i];                          \
    }                                                                                                  \
    *(u32x4*)(Ks + (buf) * 13312 + (tid >> 2) * 208 + 128 + (tid & 3) * 16) = rr;                      \
  }
  ATT_LOAD(0)
  __syncthreads();
  ATT_STORE(0)
  __syncthreads();
  f32x4 o[2][4];
#pragma unroll
  for (int qs = 0; qs < 2; ++qs)
#pragma unroll
    for (int n = 0; n < 4; ++n) o[qs][n] = f32x4{0.f, 0.f, 0.f, 0.f};
  float mrun[2] = {-1e30f, -1e30f}, lrun[2] = {0.f, 0.f};
  for (int kt = 0; kt < ntiles; ++kt) {
    const int cur = kt & 1;
    if (kt + 1 < ntiles) ATT_LOAD(kt + 1)
    if (kt < myt) {
      f32x4 s[2][4];
      const char* kb = Ks + cur * 13312 + fr * 208 + fq * 16;
#pragma unroll
      for (int t = 0; t < 4; ++t) {
        s[0][t] = f32x4{0.f, 0.f, 0.f, 0.f};
        s[1][t] = f32x4{0.f, 0.f, 0.f, 0.f};
#pragma unroll
        for (int ks = 0; ks < 3; ++ks) {
          const bf16x8 a = *(const bf16x8*)(kb + t * 16 * 208 + ks * 64);
          s[0][t] = MFMA16(a, qf[0][ks], s[0][t]);
          s[1][t] = MFMA16(a, qf[1][ks], s[1][t]);
        }
      }
      if (kt * 64 + 64 > nkeys) {
#pragma unroll
        for (int t = 0; t < 4; ++t)
#pragma unroll
          for (int j = 0; j < 4; ++j)
            if (kt * 64 + t * 16 + fq * 4 + j >= nkeys) { s[0][t][j] = -1e30f; s[1][t][j] = -1e30f; }
      }
      bf16x8 pb[2][2];
#pragma unroll
      for (int qs = 0; qs < 2; ++qs) {
        float mx = s[qs][0][0];
#pragma unroll
        for (int t = 0; t < 4; ++t)
#pragma unroll
          for (int j = 0; j < 4; ++j) mx = fmaxf(mx, s[qs][t][j]);
        mx = fmaxf(mx, __shfl_xor(mx, 16, 64));
        mx = fmaxf(mx, __shfl_xor(mx, 32, 64));
        const float mnew = fmaxf(mrun[qs], mx);
        const float alpha = __builtin_amdgcn_exp2f(mrun[qs] - mnew);
        mrun[qs] = mnew;
        float psum = 0.f;
#pragma unroll
        for (int t = 0; t < 4; ++t)
#pragma unroll
          for (int j = 0; j < 4; ++j) {
            const float pv = __builtin_amdgcn_exp2f(s[qs][t][j] - mnew);
            s[qs][t][j] = pv;
            psum += pv;
          }
        lrun[qs] = lrun[qs] * alpha + psum;
#pragma unroll
        for (int n = 0; n < 4; ++n) {
          o[qs][n][0] *= alpha; o[qs][n][1] *= alpha; o[qs][n][2] *= alpha; o[qs][n][3] *= alpha;
        }
#pragma unroll
        for (int s2 = 0; s2 < 2; ++s2) {
          union { u32x4 u; bf16x8 v; } cv;
          cv.u.x = pk2(s[qs][2 * s2][0], s[qs][2 * s2][1]); cv.u.y = pk2(s[qs][2 * s2][2], s[qs][2 * s2][3]);
          cv.u.z = pk2(s[qs][2 * s2 + 1][0], s[qs][2 * s2 + 1][1]);
          cv.u.w = pk2(s[qs][2 * s2 + 1][2], s[qs][2 * s2 + 1][3]);
          pb[qs][s2] = cv.v;
        }
      }
      const char* vb = Vs + cur * 9216 + fr * 144 + fq * 8;
#pragma unroll
      for (int n = 0; n < 4; ++n)
#pragma unroll
        for (int s2 = 0; s2 < 2; ++s2) {
          const u32x2 lo = *(const u32x2*)(vb + n * 16 * 144 + s2 * 64);
          const u32x2 hi = *(const u32x2*)(vb + n * 16 * 144 + s2 * 64 + 32);
          union { u32x4 u; bf16x8 v; } cv;
          cv.u.x = lo.x; cv.u.y = lo.y; cv.u.z = hi.x; cv.u.w = hi.y;
          o[0][n] = MFMA16(cv.v, pb[0][s2], o[0][n]);
          o[1][n] = MFMA16(cv.v, pb[1][s2], o[1][n]);
        }
    }
    if (kt + 1 < ntiles) ATT_STORE(cur ^ 1)
    __syncthreads();
  }
#pragma unroll
  for (int qs = 0; qs < 2; ++qs) {
    float lr = lrun[qs];
    lr += __shfl_xor(lr, 16, 64);
    lr += __shfl_xor(lr, 32, 64);
    const float inv = 1.f / lr;
    if (!smp || (wid == 0 && qs == 0)) {
#pragma unroll
      for (int n = 0; n < 4; ++n)
        *(u32x2*)(ab + qrow[qs] * 512 + hh * 64 + n * 16 + fq * 4) =
            pack4(o[qs][n][0] * inv, o[qs][n][1] * inv, o[qs][n][2] * inv, o[qs][n][3] * inv);
    }
  }
#undef ATT_LOAD
#undef ATT_STORE
}

__device__ void run_phase(const Params& p, int ph, char* smem, int* s_item, int rep) {
  char* ws = p.ws;
  const int nb = gridDim.x, bid = blockIdx.x;
  if (ph == 0 && PM(13)) {
    for (int i = bid * 256 + otid(); i < 2064 * 16; i += nb * 256) {
      const int pos = i >> 4, j = i & 15;
      const float inv = expf(-logf(10000.0f) * (float)j / 16.0f);
      const float ang = (float)pos * inv;
      float sn, cs;
      sincosf(ang, &sn, &cs);
      ((f32x2*)(ws + B_ROPE))[i] = f32x2{cs, sn};
    }
    if (bid == 0 && otid() < 64) ((int*)(ws + B_CNT))[otid()] = 0;
    if (bid == 0) for (int i = otid(); i < XCD_BAR_WORDS; i += 256) ((unsigned*)(ws + B_BAR))[i] = 0u;
    row_update(p, 0, 0.f, nullptr);
    convert_layer(p, 0, smem);
    return;
  }
  const int l = (ph - 1) / 13, st = (ph - 1) % 13;
  const u16* xb = (const u16*)(ws + B_XB);
  const float* rsx = (const float*)(ws + B_RSX);
  u16* big = (u16*)(ws + B_BIG);
  float* y = (float*)(ws + B_Y);
  switch (st) {
    case 0:
    case 10: if (PM(0)) {
      const u16* W = (const u16*)(ws + (st == 0 ? W_GU1 : W_GU2));
      zero_y_sample(y);
      ffn_up_phase(xb, W, rsx, big, smem);
    } break;
    case 1:
    case 11: if (PM(1)) {
      const u16* W = (const u16*)(ws + (st == 1 ? W_D1 : W_D2));
      gemm_f32_phase(big, DFF, DFF, W, y, 11, smem);
    } break;
    case 2: if (PM(2)) row_update(p, 1, 0.5f, p.in[7] + l * 1024); break;
    case 3: if (PM(3)) {
      const u16* W = (const u16*)(ws + W_IN);
      win_phase(xb, W, rsx, big, smem);
    } break;
    case 4: if (PM(4)) row_prep(p, l); break;
    case 5: if (PM(5)) {
      const int n_q = 129 * 6, n_kv = 257 * 8, n_cv = 520, n_gm = 544;
      bool kvpre = false;
      for (int t = bid; t < n_q + n_kv + n_cv + n_gm; t += nb) {
        int u = t;
        if (u < n_cv) {
          if (PM(18)) conv_item(p, l, u, smem);
        } else if ((u -= n_cv) < n_gm) {
          if (PM(19)) gmlp_item(p, l, u, smem);
        } else if ((u -= n_gm) < n_q) {
          if (PM(17))
          q_tile(big, (const u16*)(ws + W_UQ), (const float*)(ws + B_RSQ), (const f32x2*)(ws + B_ROPE),
                 (u16*)(ws + B_Q), u / 6, u % 6, smem);
        } else {
          u -= n_q;
          const int u2 = u + nb;
          const bool hn = (t + nb) < n_q + n_kv + n_cv + n_gm;
          if (PM(16))
          kv_tile((const u16*)(ws + B_LAT), (const u16*)(ws + W_UKV), (u16*)(ws + B_KN), (u16*)(ws + B_VTP),
                  (u16*)(ws + B_VTS), u >> 3, u & 7, kvpre, hn, u2 >> 3, u2 & 7, smem);
          kvpre = hn;
        }
      }
    } break;
    case 6: if (PM(6)) {
      int* cnt = (int*)(ws + B_CNT) + l + 4 * rep;
      for (;;) {
        if (otid() == 0) *s_item = atomicAdd(cnt, 1);
        __syncthreads();
        const int idx = *s_item;
        __syncthreads();
        if (idx >= 1088) break;
        attn_item(p, idx, smem);
      }
    } break;
    case 7: if (PM(7)) {
      zero_y_sample(y);
      {
        const int bound = 8 * ((129 * 16 + 7) >> 3);
        int i = bid, mt, nt;
        bool have = next_tile(i, nb, bound, 129, 16, mt, nt), pre = false;
        while (have) {
          int i2 = i + nb, mt2 = 0, nt2 = 0;
          const bool hn = next_tile(i2, nb, bound, 129, 16, mt2, nt2);
          merge_tile((const u16*)(ws + B_A), (const u16*)(ws + B_YB), (const u16*)(ws + B_YC), (const u16*)(ws + B_YD),
                     (const u16*)(ws + W_BRA), (const u16*)(ws + W_BRB), (const u16*)(ws + W_BRC),
                     (const u16*)(ws + W_BRD), big, (u16*)(ws + B_MG), mt, nt, pre, hn, mt2, nt2, smem);
          pre = hn; i = i2; mt = mt2; nt = nt2; have = hn;
        }
      }
    } break;
    case 8: if (PM(8)) {
      gemm_f32_phase((const u16*)(ws + B_MG), 1024, 1024, (const u16*)(ws + W_O), y, 4, smem);
    } break;
    case 9: if (PM(2)) row_update(p, 1, 1.0f, p.in[11] + l * 1024); break;
    case 12:
      if (PM(2)) row_update(p, 1, 0.5f, p.in[32] + l * 1024);
      if (PM(12)) if (l + 1 < 4) convert_layer(p, l + 1, smem);
      break;
    default: break;
  }
}

constexpr int NPHASES = 1 + 13 * 4;

__global__ void __launch_bounds__(256, 2) mega(Params p, int ph0, int ph1) {
  __shared__ __attribute__((aligned(16))) char smem[65536];
  __shared__ u32x4 s_misc;
  cg::grid_group grid = cg::this_grid();
  if (threadIdx.x == 0) s_misc = u32x4{0u, 0u, 0u, 0u};
  __syncthreads();
  int* s_item = (int*)&s_misc + 2;
  XcdBarrier xb;
  xb.bar = (unsigned*)(p.ws + B_BAR); xb.x = 0u; xb.st = (volatile LAS unsigned*)&s_misc;
  for (int ph = ph0; ph < ph1; ++ph) {
    int reps = 1;
#ifdef DUPMASK
    if (ph > 0 && ((DUPMASK >> ((ph - 1) % 13)) & 1)) reps = 2;
#endif
    for (int rep = 0; rep < reps; ++rep) run_phase(p, ph, smem, s_item, rep);
    if (ph + 1 < ph1) {
      if (ph == ph0) {
        grid.sync();
        xb = xcd_barrier_post((unsigned*)(p.ws + B_BAR), (volatile LAS unsigned*)&s_misc);
      } else {
        xcd_barrier(xb);
      }
    }
  }
}

extern "C" void kernel_launch(void* const* d_in, const int* in_sizes, int n_in, void* d_out, int out_size, void* d_ws,
                              size_t ws_size, hipStream_t stream) {
  (void)in_sizes; (void)n_in; (void)out_size;
  if (ws_size < WS_NEED) { fprintf(stderr, "ws too small: %zu < %zu\n", ws_size, (size_t)WS_NEED); return; }
  static int grid_blocks = 0;
  if (!grid_blocks) {
    int dev = 0, cus = 0, per_cu = 0;
    hipGetDevice(&dev);
    hipDeviceGetAttribute(&cus, hipDeviceAttributeMultiprocessorCount, dev);
    hipOccupancyMaxActiveBlocksPerMultiprocessor(&per_cu, mega, 256, 0);
    if (per_cu < 1) per_cu = 1;
    if (per_cu > 2) per_cu = 2;
    grid_blocks = cus * per_cu;
  }
  Params p{};
  for (int i = 0; i < 35; ++i) p.in[i] = (const float*)d_in[i];
  p.out = (float*)d_out;
  p.ws = (char*)d_ws;
#if COOP
  int ph0 = 0, ph1 = NPHASES;
  void* args[] = {&p, &ph0, &ph1};
  hipError_t e = hipLaunchCooperativeKernel((void*)mega, dim3(grid_blocks), dim3(256), args, 0, stream);
  if (e != hipSuccess) fprintf(stderr, "cooperative launch failed: %s (grid %d)\n", hipGetErrorString(e), grid_blocks);
#else
  for (int ph = 0; ph < NPHASES; ++ph) mega<<<dim3(grid_blocks), dim3(256), 0, stream>>>(p, ph, ph + 1);
#endif
}
```

```cpp
#include <hip/hip_runtime.h>
#include <hip/hip_cooperative_groups.h>
#include <cstdio>
namespace cg = cooperative_groups;

#ifndef COOP
#define COOP 1
#endif
#ifndef PMASK
#define PMASK 0xffffffffu
#endif
#define PM(k) ((PMASK >> (k)) & 1u)

typedef unsigned short u16;
using bf16x8 = __attribute__((ext_vector_type(8))) short;
using f32x4 = __attribute__((ext_vector_type(4))) float;
using f32x2 = __attribute__((ext_vector_type(2))) float;
using u32x4 = __attribute__((ext_vector_type(4))) unsigned;
using u32x2 = __attribute__((ext_vector_type(2))) unsigned;

#define EPSV 1e-6f
#define MFMA16(a, b, c) __builtin_amdgcn_mfma_f32_16x16x32_bf16((a), (b), (c), 0, 0, 0)

struct Params {
  const float* in[35];
  float* out;
  char* ws;
};

constexpr int MROWS = 16512;
constexpr int MPR = 16384;
constexpr int HLD = 6656;
constexpr int DIN = 6560;
constexpr int DFF = 2816;
constexpr int C_CQ = 0, C_KV = 384, C_KR = 640, C_GA = 672, C_GG = 928, C_U = 1184, C_V = 1440, C_BG = 1696,
              C_CG = 1952, C_HD = 2208, C_GATE = 2464;
constexpr int KVROWS = 32896;
constexpr int SKEYS = 2064;
constexpr int VSTR_S = 2112;

constexpr size_t O_YP = 0;
constexpr size_t O_YS = O_YP + 16777216;
constexpr size_t O_LATP = O_YS + 131072;
constexpr size_t O_KRP = O_LATP + 16777216;
constexpr size_t O_CBP = O_KRP + 2097152;
constexpr size_t O_CDP = O_CBP + 245760;
constexpr size_t O_LATS = O_CDP + 16384;
constexpr size_t O_KRS = O_LATS + 131072;
constexpr size_t O_CBS = O_KRS + 16384;
constexpr size_t O_VS = O_CBS + 245760;
constexpr size_t O_CDS = O_VS + 131072;

constexpr size_t W_GU1 = 0;
constexpr size_t W_D1 = W_GU1 + (size_t)5632 * 1024 * 2;
constexpr size_t W_IN = W_D1 + (size_t)1024 * 2816 * 2;
constexpr size_t W_UQ = W_IN + (size_t)HLD * 1024 * 2;
constexpr size_t W_UKV = W_UQ + (size_t)768 * 384 * 2;
constexpr size_t W_BRA = W_UKV + (size_t)1024 * 256 * 2;
constexpr size_t W_BRB = W_BRA + (size_t)1024 * 512 * 2;
constexpr size_t W_BRC = W_BRB + (size_t)1024 * 256 * 2;
constexpr size_t W_BRD = W_BRC + (size_t)1024 * 256 * 2;
constexpr size_t W_O = W_BRD + (size_t)1024 * 256 * 2;
constexpr size_t W_GU2 = W_O + (size_t)1024 * 1024 * 2;
constexpr size_t W_D2 = W_GU2 + (size_t)5632 * 1024 * 2;
constexpr size_t B_XB = W_D2 + (size_t)1024 * 2816 * 2;
constexpr size_t B_RSX = B_XB + (size_t)MROWS * 1024 * 2;
constexpr size_t B_RSQ = B_RSX + (size_t)MROWS * 4;
constexpr size_t B_ROPE = B_RSQ + (size_t)MROWS * 4;
constexpr size_t B_CNT = B_ROPE + (size_t)2064 * 16 * 8;
constexpr size_t B_BAR = B_CNT + 256;
constexpr size_t B_BIG = B_BAR + 16384;
constexpr size_t B_Y = B_BIG + (size_t)MROWS * HLD * 2;
constexpr size_t B_Q = B_Y;
constexpr size_t B_KN = B_Q + (size_t)MROWS * 768 * 2;
constexpr size_t B_VTP = B_KN + (size_t)KVROWS * 512 * 2;
constexpr size_t B_VTS = B_VTP + (size_t)64 * 64 * 2048 * 2;
constexpr size_t B_LAT = B_VTS + (size_t)64 * 64 * VSTR_S * 2;
constexpr size_t B_KR = B_LAT + (size_t)KVROWS * 256 * 2;
constexpr size_t B_A = B_KR + (size_t)KVROWS * 32 * 2;
constexpr size_t B_YB = B_A + (size_t)MROWS * 512 * 2;
constexpr size_t B_YC = B_YB + (size_t)MROWS * 256 * 2;
constexpr size_t B_YD = B_YC + (size_t)MROWS * 256 * 2;
constexpr size_t B_MG = B_YD + (size_t)MROWS * 256 * 2;
constexpr size_t WS_NEED = B_MG + (size_t)MROWS * 1024 * 2;
static_assert(B_Y + (size_t)MROWS * 1024 * 4 <= B_VTS, "y alias overflow");

__device__ __forceinline__ int otid() { int t = threadIdx.x; asm volatile("" : "+v"(t)); return t; }
__device__ __forceinline__ u16 f2bf(float f) { return __builtin_bit_cast(u16, (__bf16)f); }
__device__ __forceinline__ float bf2f(u16 h) { return __uint_as_float(((unsigned)h) << 16); }
typedef __bf16 hwbf16x2 __attribute__((ext_vector_type(2)));
__device__ __forceinline__ unsigned pk2(float a, float b) {
  f32x2 v = {a, b};
  return __builtin_bit_cast(unsigned, __builtin_convertvector(v, hwbf16x2));
}
__device__ __forceinline__ u32x2 pack4(float a, float b, float c, float d) {
  u32x2 r; r.x = pk2(a, b); r.y = pk2(c, d); return r;
}
__device__ __forceinline__ void unpack4(u32x2 v, float (&f)[4]) {
  f[0] = __uint_as_float(v.x << 16); f[1] = __uint_as_float(v.x & 0xffff0000u);
  f[2] = __uint_as_float(v.y << 16); f[3] = __uint_as_float(v.y & 0xffff0000u);
}
__device__ __forceinline__ float wave_sum(float v) {
#pragma unroll
  for (int o = 32; o > 0; o >>= 1) v += __shfl_xor(v, o, 64);
  return v;
}
__device__ __forceinline__ float sigm(float x) { return __builtin_amdgcn_rcpf(1.f + __expf(-x)); }

#define XB_TMO      128
#define XB_XCNT(j)  (256  + 64 * (j))
#define XB_XSUB(j)  (1280 + 64 * (j))
#define XB_XGEN(j)  (2304 + 64 * (j))
#define XB_TOP      3328
#define XB_TOPGEN   3392
#define XCD_BAR_WORDS 3456
#define XB_SPIN_CAP (1u << 18)
#define LAS __attribute__((address_space(3)))
__device__ __forceinline__ unsigned xb_ld(unsigned* p) { return __hip_atomic_load(p, __ATOMIC_RELAXED, __HIP_MEMORY_SCOPE_AGENT); }
__device__ __forceinline__ unsigned xb_add(unsigned* p, unsigned v) { return __hip_atomic_fetch_add(p, v, __ATOMIC_RELAXED, __HIP_MEMORY_SCOPE_AGENT); }
__device__ __forceinline__ unsigned xb_xcc_id() { return (unsigned)__builtin_amdgcn_s_getreg((3 << 11) | 20) & 0xFu; }
#define XB_SPIN(cond, bar) do { unsigned _sp = 0; while (cond) { __builtin_amdgcn_s_sleep(1); \
    if ((++_sp & 255u) == 0u) { if (xb_ld(&(bar)[XB_TMO])) break; if (_sp > XB_SPIN_CAP) { atomicAdd(&(bar)[XB_TMO], 1u); break; } } } } while (0)
struct XcdBarrier { unsigned* bar; unsigned x; volatile LAS unsigned* st; };
__device__ __forceinline__ XcdBarrier xcd_barrier_post(unsigned* bar, volatile LAS unsigned* st) {
  XcdBarrier b; b.bar = bar; b.x = xb_xcc_id(); b.st = st;
  if (threadIdx.x == 0) (void)xb_add(&bar[XB_XCNT(b.x)], 1u);
  return b;
}
__device__ __forceinline__ void xcd_barrier_complete(unsigned* bar, unsigned x, unsigned& nloc, unsigned& nx) {
  const unsigned G = gridDim.x * gridDim.y * gridDim.z;
  unsigned sum, cnt, mine, sp = 0u;
  for (;;) {
    sum = 0u; cnt = 0u; mine = 0u;
#pragma unroll
    for (unsigned j = 0; j < 16; ++j) { const unsigned c = xb_ld(&bar[XB_XCNT(j)]); sum += c; cnt += (c > 0u) ? 1u : 0u; mine = (j == x) ? c : mine; }
    if (sum == G) break;
    __builtin_amdgcn_s_sleep(1);
    if ((++sp & 255u) == 0u) { if (xb_ld(&bar[XB_TMO])) break; if (sp > XB_SPIN_CAP) { atomicAdd(&bar[XB_TMO], 1u); break; } }
  }
  nloc = mine > 0u ? mine : 1u; nx = cnt > 0u ? cnt : 1u;
}
__device__ __forceinline__ void xcd_barrier(const XcdBarrier& b) {
  asm volatile("s_waitcnt vmcnt(0)" ::: "memory");
  __syncthreads();
  if (threadIdx.x == 0) {
    unsigned* bar = b.bar;
    __builtin_amdgcn_s_waitcnt(0);
    unsigned nloc = b.st[0], nx = b.st[1];
    if (nloc == 0u) { xcd_barrier_complete(bar, b.x, nloc, nx); b.st[0] = nloc; b.st[1] = nx; }
    const unsigned old = xb_add(&bar[XB_XSUB(b.x)], 1u);
    const unsigned gen = old / nloc;
    if (old + 1u == (gen + 1u) * nloc) {
      __builtin_amdgcn_fence(__ATOMIC_RELEASE, "agent");
      asm volatile("s_waitcnt vmcnt(0)" ::: "memory");
      const unsigned og = xb_add(&bar[XB_TOP], 1u);
      const unsigned tg = og / nx;
      if (og + 1u == (tg + 1u) * nx) xb_add(&bar[XB_TOPGEN], 1u);
      else XB_SPIN(xb_ld(&bar[XB_TOPGEN]) == tg, bar);
      __builtin_amdgcn_fence(__ATOMIC_ACQUIRE, "agent");
      xb_add(&bar[XB_XGEN(b.x)], 1u);
      asm volatile("s_waitcnt vmcnt(0)" ::: "memory");
    } else {
      XB_SPIN(xb_ld(&bar[XB_XGEN(b.x)]) == gen, bar);
      __builtin_amdgcn_fence(__ATOMIC_ACQUIRE, "agent");
      asm volatile("s_waitcnt vmcnt(0)" ::: "memory");
    }
  }
  __syncthreads();
}

#define DSR(dst, addr, OFF) asm volatile("ds_read_b128 %0, %1 offset:" #OFF : "=v"(dst) : "v"(addr))
__device__ __forceinline__ unsigned lds_addr(const char* p) { return (unsigned)(size_t)(LAS const char*)p; }

__device__ __forceinline__ int lds_off(int r, int c) {
  int st = (r >> 4) * 2 + (c >> 5), rr = r & 15, cc = c & 31, ob = rr * 64 + cc * 2;
  return st * 1024 + (ob ^ (((ob >> 9) & 1) << 5));
}

template <int NN>
__device__ __forceinline__ void gemm_first(const u16* __restrict__ A, int lda, const u16* __restrict__ Bt, int ldb,
                                           int row0, int col0, char* smem) {
  const int tid = otid(), lane = tid & 63, wid = tid >> 6;
  const int l2 = lane ^ ((lane >> 5) << 1);
  const int Rl = (wid >> 1) * 16 + (l2 >> 2), Cl = (wid & 1) * 32 + (l2 & 3) * 8;
  const u16* ag = A + (size_t)(row0 + Rl) * lda + Cl;
  const u16* bg = Bt + (size_t)(col0 + Rl) * ldb + Cl;
  const size_t astep = (size_t)32 * lda, bstep = (size_t)32 * ldb;
  char* dA = smem + tid * 16;
  char* dB = smem + 32768 + tid * 16;
#pragma unroll
  for (int i = 0; i < 4; ++i)
    __builtin_amdgcn_global_load_lds((const unsigned*)(ag + i * astep), (LAS unsigned*)(dA + i * 4096), 16, 0, 0);
#pragma unroll
  for (int i = 0; i < NN; ++i)
    __builtin_amdgcn_global_load_lds((const unsigned*)(bg + i * bstep), (LAS unsigned*)(dB + i * 4096), 16, 0, 0);
}

template <int NN>
__device__ __forceinline__ void gemm_main(const u16* __restrict__ A, int lda, const u16* __restrict__ Bt, int ldb,
                                          int K, int row0, int col0, f32x4 (&acc)[4][NN], char* smem,
                                          bool pre = false) {
  const int tid = otid(), lane = tid & 63, wid = tid >> 6, wr = wid >> 1, wc = wid & 1;
  const int fr = lane & 15, fq = lane >> 4;
  const int l2 = lane ^ ((lane >> 5) << 1);
  const int Rl = (wid >> 1) * 16 + (l2 >> 2), Cl = (wid & 1) * 32 + (l2 & 3) * 8;
  const u16* ag = A + (size_t)(row0 + Rl) * lda + Cl;
  const u16* bg = Bt + (size_t)(col0 + Rl) * ldb + Cl;
  const size_t astep = (size_t)32 * lda, bstep = (size_t)32 * ldb;
  const int rbase = (fr * 64 + fq * 16) ^ (((fr >> 3) & 1) << 5);
  char* sA = smem;
  char* sB = smem + 32768;
  char* dA = sA + tid * 16;
  char* dB = sB + tid * 16;
#define GLDS(gp, lp) __builtin_amdgcn_global_load_lds((const unsigned*)(gp), (LAS unsigned*)(lp), 16, 0, 0)
  if (!pre) {
    __syncthreads();
#pragma unroll
    for (int i = 0; i < 4; ++i) GLDS(ag + i * astep, dA + i * 4096);
#pragma unroll
    for (int i = 0; i < NN; ++i) GLDS(bg + i * bstep, dB + i * 4096);
  }
  asm volatile("s_waitcnt vmcnt(0)" ::: "memory");
  __syncthreads();
  const int nk = K >> 6;
  for (int kt = 0; kt < nk; ++kt) {
    const int cur = kt & 1;
    if (kt + 1 < nk) {
      const int ko = (kt + 1) * 64;
      char* na = dA + (cur ^ 1) * 16384;
      char* nb = dB + (cur ^ 1) * 16384;
#pragma unroll
      for (int i = 0; i < 4; ++i) GLDS(ag + i * astep + ko, na + i * 4096);
#pragma unroll
      for (int i = 0; i < NN; ++i) GLDS(bg + i * bstep + ko, nb + i * 4096);
    }
    const char* a_s = sA + cur * 16384 + rbase + wr * 8192;
    const char* b_s = sB + cur * 16384 + rbase + wc * (NN * 2048);
    {
      const unsigned aaddr = lds_addr(a_s), baddr = lds_addr(b_s);
      bf16x8 af[2][4], bfv[2][NN];
      DSR(af[0][0], aaddr, 0); DSR(af[0][1], aaddr, 2048); DSR(af[0][2], aaddr, 4096); DSR(af[0][3], aaddr, 6144);
      DSR(bfv[0][0], baddr, 0); DSR(bfv[0][1], baddr, 2048);
      if (NN == 4) { DSR(bfv[0][NN - 2], baddr, 4096); DSR(bfv[0][NN - 1], baddr, 6144); }
      DSR(af[1][0], aaddr, 1024); DSR(af[1][1], aaddr, 3072); DSR(af[1][2], aaddr, 5120); DSR(af[1][3], aaddr, 7168);
      DSR(bfv[1][0], baddr, 1024); DSR(bfv[1][1], baddr, 3072);
      if (NN == 4) { DSR(bfv[1][NN - 2], baddr, 5120); DSR(bfv[1][NN - 1], baddr, 7168); }
      if (NN == 4) {
        asm volatile("s_waitcnt lgkmcnt(8)"
                     : "+v"(af[0][0]), "+v"(af[0][1]), "+v"(af[0][2]), "+v"(af[0][3]), "+v"(bfv[0][0]),
                       "+v"(bfv[0][1]), "+v"(bfv[0][NN - 2]), "+v"(bfv[0][NN - 1]));
      } else {
        asm volatile("s_waitcnt lgkmcnt(6)"
                     : "+v"(af[0][0]), "+v"(af[0][1]), "+v"(af[0][2]), "+v"(af[0][3]), "+v"(bfv[0][0]),
                       "+v"(bfv[0][1]));
      }
#pragma unroll
      for (int m = 0; m < 4; ++m)
#pragma unroll
        for (int n = 0; n < NN; ++n) acc[m][n] = MFMA16(af[0][m], bfv[0][n], acc[m][n]);
      if (NN == 4) {
        asm volatile("s_waitcnt lgkmcnt(0)"
                     : "+v"(af[1][0]), "+v"(af[1][1]), "+v"(af[1][2]), "+v"(af[1][3]), "+v"(bfv[1][0]),
                       "+v"(bfv[1][1]), "+v"(bfv[1][NN - 2]), "+v"(bfv[1][NN - 1]));
      } else {
        asm volatile("s_waitcnt lgkmcnt(0)"
                     : "+v"(af[1][0]), "+v"(af[1][1]), "+v"(af[1][2]), "+v"(af[1][3]), "+v"(bfv[1][0]),
                       "+v"(bfv[1][1]));
      }
#pragma unroll
      for (int m = 0; m < 4; ++m)
#pragma unroll
        for (int n = 0; n < NN; ++n) acc[m][n] = MFMA16(af[1][m], bfv[1][n], acc[m][n]);
      __builtin_amdgcn_sched_barrier(0);
    }
    asm volatile("s_waitcnt vmcnt(0)" ::: "memory");
    __syncthreads();
  }
#undef GLDS
}

#define ZERO_ACC(acc)                                  \
  _Pragma("unroll") for (int m_ = 0; m_ < 4; ++m_)     \
  _Pragma("unroll") for (int n_ = 0; n_ < 4; ++n_) acc[m_][n_] = f32x4{0.f, 0.f, 0.f, 0.f};

#define TILE_IDS                                                            \
  const int tid = otid(), lane = tid & 63, wid = tid >> 6;             \
  const int wr = wid >> 1, wc = wid & 1, fr = lane & 15, fq = lane >> 4;    \
  (void)tid; (void)lane; (void)wid; (void)wr; (void)wc; (void)fr; (void)fq;

__device__ void ffn_up_tile(const u16* xb, const u16* Wt, const float* rsx, u16* Hff, int mt, int nt, char* smem) {
  TILE_IDS
  f32x4 acc[4][4];
  ZERO_ACC(acc)
  gemm_main<4>(xb, 1024, Wt, 1024, 1024, mt * 128, nt * 128, acc, smem);
#pragma unroll
  for (int m = 0; m < 4; ++m)
#pragma unroll
    for (int j = 0; j < 4; ++j) {
      const int row = mt * 128 + wr * 64 + m * 16 + fq * 4 + j;
      const float r = rsx[row];
#pragma unroll
      for (int n = 0; n < 2; ++n) {
        const float g = acc[m][n][j] * r, u = acc[m][n + 2][j] * r;
        const float v = g * sigm(g) * u;
        Hff[(size_t)row * DFF + nt * 64 + wc * 32 + n * 16 + fr] = f2bf(v);
      }
    }
}

__device__ __forceinline__ bool tile_map(int i, int MT, int NT, int& mt, int& nt) {
  const int T = MT * NT, chunk = (T + 7) >> 3;
  const int x = i & 7, q = i >> 3;
  if (q >= chunk) return false;
  const int t = x * chunk + q;
  if (t >= T) return false;
  const int full = NT >> 3, pb = MT * 8;
  const int np = t / pb;
  if (np < full) { const int rem = t - np * pb; mt = rem >> 3; nt = np * 8 + (rem & 7); }
  else { const int wl = NT & 7; const int rem = t - full * pb; mt = rem / wl; nt = full * 8 + rem % wl; }
  return true;
}
#define FOR_TILES(MT, NT) \
  for (int i_ = bid, mt, nt; i_ < 8 * (((MT) * (NT) + 7) >> 3); i_ += nb) if (tile_map(i_, (MT), (NT), mt, nt))

#define GLDS(gp, lp) __builtin_amdgcn_global_load_lds((const unsigned*)(gp), (LAS unsigned*)(lp), 16, 0, 0)
__device__ __forceinline__ void big_issue(const u16* ag, const u16* bg, size_t astep, size_t bstep, char* dst) {
#pragma unroll
  for (int i = 0; i < 2; ++i) GLDS(ag + i * astep, dst + i * 4096);
#pragma unroll
  for (int i = 0; i < 4; ++i) GLDS(bg + i * bstep, dst + 8192 + i * 4096);
}
#undef GLDS

__device__ __forceinline__ bool next_tile(int& i, int nb, int bound, int MT, int NT, int& mt, int& nt) {
  while (i < bound) {
    if (tile_map(i, MT, NT, mt, nt)) return true;
    i += nb;
  }
  return false;
}

template <class Epi>
__device__ __forceinline__ void big_gemm_phase(const u16* __restrict__ A, int lda, const u16* __restrict__ Bt, int ldb,
                                               int K, int MT, int NT, char* smem, const float* __restrict__ rowscale, Epi epi) {
  const int tid = otid(), lane = tid & 63, wid = tid >> 6, wr = wid >> 1, wc = wid & 1;
  const int fr = lane & 15, fq = lane >> 4;
  const int l2 = lane ^ ((lane >> 5) << 1);
  const int Rl = wid * 16 + (l2 >> 2), Cl = (l2 & 3) * 8;
  const size_t astep = (size_t)64 * lda, bstep = (size_t)64 * ldb;
  const int rbase = (fr * 64 + fq * 16) ^ (((fr >> 3) & 1) << 5);
  const unsigned sbase = lds_addr(smem);
  const unsigned aoff = rbase + wr * 4096, boff = 8192 + rbase + wc * 8192;
  char* dst = smem + tid * 16;
  const int nb = gridDim.x, bound = 8 * ((MT * NT + 7) >> 3), nk = K >> 5;
  int i = blockIdx.x, mt, nt;
  bool have = next_tile(i, nb, bound, MT, NT, mt, nt);
  if (!have) return;
  const u16* ag = A + (size_t)(mt * 128 + Rl) * lda + Cl;
  const u16* bg = Bt + (size_t)(nt * 256 + Rl) * ldb + Cl;
  __syncthreads();
  big_issue(ag, bg, astep, bstep, dst);
  while (have) {
    f32x4 acc[4][8];
#pragma unroll
    for (int m = 0; m < 4; ++m)
#pragma unroll
      for (int n = 0; n < 8; ++n) acc[m][n] = f32x4{0.f, 0.f, 0.f, 0.f};
    float rs[4];
#pragma unroll
    for (int m = 0; m < 4; ++m) rs[m] = rowscale[mt * 128 + wr * 64 + m * 16 + fr];
    asm volatile("s_waitcnt vmcnt(0)" ::: "memory");
    __syncthreads();
    for (int kt = 0; kt < nk; ++kt) {
      const int cur = kt & 1;
      if (kt + 1 < nk) big_issue(ag + (kt + 1) * 32, bg + (kt + 1) * 32, astep, bstep, dst + (cur ^ 1) * 24576);
      bf16x8 af[4], bfv[8];
      {
        const unsigned aaddr = sbase + cur * 24576 + aoff, baddr = sbase + cur * 24576 + boff;
        DSR(af[0], aaddr, 0); DSR(af[1], aaddr, 1024); DSR(af[2], aaddr, 2048); DSR(af[3], aaddr, 3072);
        DSR(bfv[0], baddr, 0); DSR(bfv[1], baddr, 1024); DSR(bfv[2], baddr, 2048); DSR(bfv[3], baddr, 3072);
        DSR(bfv[4], baddr, 4096); DSR(bfv[5], baddr, 5120); DSR(bfv[6], baddr, 6144); DSR(bfv[7], baddr, 7168);
        asm volatile("s_waitcnt lgkmcnt(0)"
                     : "+v"(af[0]), "+v"(af[1]), "+v"(af[2]), "+v"(af[3]), "+v"(bfv[0]), "+v"(bfv[1]), "+v"(bfv[2]),
                       "+v"(bfv[3]), "+v"(bfv[4]), "+v"(bfv[5]), "+v"(bfv[6]), "+v"(bfv[7]));
      }
#pragma unroll
      for (int m = 0; m < 4; ++m)
#pragma unroll
        for (int n = 0; n < 8; ++n) acc[m][n] = MFMA16(bfv[n], af[m], acc[m][n]);
      __builtin_amdgcn_sched_barrier(0);
      asm volatile("s_waitcnt vmcnt(0)" ::: "memory");
      __syncthreads();
    }
    const int cmt = mt, cnt = nt;
    i += nb;
    have = next_tile(i, nb, bound, MT, NT, mt, nt);
    if (have) {
      ag = A + (size_t)(mt * 128 + Rl) * lda + Cl;
      bg = Bt + (size_t)(nt * 256 + Rl) * ldb + Cl;
      big_issue(ag, bg, astep, bstep, dst);
    }
    epi(acc, rs, cmt, cnt, wr, wc, fr, fq, smem + 24576);
  }
}

#define ZERO_ACC8(acc)                                 \
  _Pragma("unroll") for (int m_ = 0; m_ < 4; ++m_)     \
  _Pragma("unroll") for (int n_ = 0; n_ < 8; ++n_) acc[m_][n_] = f32x4{0.f, 0.f, 0.f, 0.f};

__device__ void ffn_up_phase(const u16* xb, const u16* Wt, const float* rsx, u16* Hff, char* smem) {
  big_gemm_phase(xb, 1024, Wt, 1024, 1024, 129, 22, smem, rsx,
                 [&](f32x4 (&acc)[4][8], const float (&rs)[4], int mt, int nt, int wr, int wc, int fr, int fq, char* stg) {
#pragma unroll
                   for (int m = 0; m < 4; ++m) {
                     const int lr = wr * 64 + m * 16 + fr;
                     const float r = rs[m];
                     char* sp = stg + lr * 272 + (wc * 64 + fq * 4) * 2;
#pragma unroll
                     for (int n = 0; n < 4; ++n) {
                       float v[4];
#pragma unroll
                       for (int jj = 0; jj < 4; ++jj) {
                         const float g = acc[m][n][jj] * r, u = acc[m][n + 4][jj] * r;
                         v[jj] = g * sigm(g) * u;
                       }
                       *(u32x2*)(sp + n * 32) = pack4(v[0], v[1], v[2], v[3]);
                     }
                   }
                   __syncthreads();
                   const int tid = otid();
#pragma unroll
                   for (int it = 0; it < 8; ++it) {
                     const int ch = tid + 256 * it, lr = ch >> 4, c16 = ch & 15;
                     const u32x4 v = *(const u32x4*)(stg + lr * 272 + c16 * 16);
                     *(u32x4*)(Hff + (size_t)(mt * 128 + lr) * DFF + nt * 128 + c16 * 8) = v;
                   }
                 });
}

__device__ void win_phase(const u16* xb, const u16* Wt, const float* rsx, u16* h, char* smem) {
  big_gemm_phase(xb, 1024, Wt, 1024, 1024, 129, 26, smem, rsx,
                 [&](f32x4 (&acc)[4][8], const float (&rs)[4], int mt, int nt, int wr, int wc, int fr, int fq, char* stg) {
                   const int tid = otid();
#pragma unroll
                   for (int ps = 0; ps < 2; ++ps) {
                     if (ps) __syncthreads();
#pragma unroll
                     for (int m = 0; m < 4; ++m) {
                       const int lr = wr * 64 + m * 16 + fr;
                       const float r = rs[m];
                       char* sp = stg + lr * 272 + (wc * 64 + fq * 4) * 2;
#pragma unroll
                       for (int n = 0; n < 4; ++n) {
                         const int cb = nt * 256 + wc * 128 + (ps * 4 + n) * 16;
                         float v[4];
#pragma unroll
                         for (int jj = 0; jj < 4; ++jj) {
                           v[jj] = acc[m][ps * 4 + n][jj] * r;
                           if (cb >= C_GATE) v[jj] = sigm(v[jj]);
                         }
                         *(u32x2*)(sp + n * 32) = pack4(v[0], v[1], v[2], v[3]);
                       }
                     }
                     __syncthreads();
#pragma unroll
                     for (int it = 0; it < 8; ++it) {
                       const int ch = tid + 256 * it, lr = ch >> 4, c16 = ch & 15;
                       const u32x4 v = *(const u32x4*)(stg + lr * 272 + c16 * 16);
                       const int c = c16 * 8;
                       *(u32x4*)(h + (size_t)(mt * 128 + lr) * HLD + nt * 256 + (c >> 6) * 128 + ps * 64 + (c & 63)) = v;
                     }
                   }
                 });
}

struct F32Item { int mt, nt, k0, kc; bool atomic; };
__device__ __forceinline__ bool f32_item(int i, int KS, int K, F32Item& it) {
  const int bound = 1024;
  if (i >= bound + 8 * KS) return false;
  if (i < bound) {
    tile_map(i, 128, 8, it.mt, it.nt);
    it.k0 = 0; it.kc = K; it.atomic = false;
  } else {
    const int u = i - bound, kcs = K / KS;
    it.mt = 128; it.nt = u & 7; it.k0 = (u >> 3) * kcs; it.kc = kcs; it.atomic = true;
  }
  return true;
}
__device__ void gemm_f32_phase(const u16* A, int lda, int K, const u16* Wt, float* y, int KS, char* smem) {
  TILE_IDS
  const int nb = gridDim.x;
  int i = blockIdx.x;
  F32Item cur, nxt;
  bool have = f32_item(i, KS, K, cur);
  if (!have) return;
  __syncthreads();
  gemm_first<4>(A + cur.k0, lda, Wt + cur.k0, K, cur.mt * 128, cur.nt * 128, smem);
  while (have) {
    f32x4 acc[4][4];
    ZERO_ACC(acc)
    gemm_main<4>(A + cur.k0, lda, Wt + cur.k0, K, cur.kc, cur.mt * 128, cur.nt * 128, acc, smem, true);
    i += nb;
    const bool hn = f32_item(i, KS, K, nxt);
    if (hn) gemm_first<4>(A + nxt.k0, lda, Wt + nxt.k0, K, nxt.mt * 128, nxt.nt * 128, smem);
#pragma unroll
    for (int m = 0; m < 4; ++m)
#pragma unroll
      for (int j = 0; j < 4; ++j) {
        const int row = cur.mt * 128 + wr * 64 + m * 16 + fq * 4 + j;
        float* yp = y + (size_t)row * 1024 + cur.nt * 128 + wc * 64 + fr;
        if (cur.atomic) {
#pragma unroll
          for (int n = 0; n < 4; ++n)
            (void)__hip_atomic_fetch_add(yp + n * 16, acc[m][n][j], __ATOMIC_RELAXED, __HIP_MEMORY_SCOPE_AGENT);
        } else {
#pragma unroll
          for (int n = 0; n < 4; ++n) yp[n * 16] = acc[m][n][j];
        }
      }
    cur = nxt;
    have = hn;
  }
}

__device__ void zero_y_sample(float* y) {
  for (int i = blockIdx.x * 256 + otid(); i < 128 * 1024; i += gridDim.x * 256) y[(size_t)MPR * 1024 + i] = 0.f;
}

__device__ void win_tile(const u16* xb, const u16* Wt, const float* rsx, u16* h, int mt, int nt, char* smem) {
  TILE_IDS
  f32x4 acc[4][4];
  ZERO_ACC(acc)
  gemm_main<4>(xb, 1024, Wt, 1024, 1024, mt * 128, nt * 128, acc, smem);
#pragma unroll
  for (int m = 0; m < 4; ++m)
#pragma unroll
    for (int j = 0; j < 4; ++j) {
      const int row = mt * 128 + wr * 64 + m * 16 + fq * 4 + j;
      const float r = rsx[row];
#pragma unroll
      for (int n = 0; n < 4; ++n) {
        const int cb = nt * 128 + wc * 64 + n * 16;
        float v = acc[m][n][j] * r;
        if (cb >= C_GATE) v = sigm(v);
        h[(size_t)row * HLD + cb + fr] = f2bf(v);
      }
    }
}

__device__ void q_tile(const u16* h, const u16* Wt, const float* rsq, const f32x2* ropeT, u16* q, int mt, int nt,
                       char* smem) {
  TILE_IDS
  f32x4 acc[4][4];
  ZERO_ACC(acc)
  gemm_main<4>(h + C_CQ, HLD, Wt, 384, 384, mt * 128, nt * 128, acc, smem);
  const float QS = 0.10206207261596577f * 1.4426950408889634f;
  const int s0 = (nt * 128 + wc * 64) >> 4;
#pragma unroll
  for (int m = 0; m < 4; ++m)
#pragma unroll
    for (int j = 0; j < 4; ++j) {
      const int row = mt * 128 + wr * 64 + m * 16 + fq * 4 + j;
      const float r = rsq[row] * QS;
      float v[4];
#pragma unroll
      for (int n = 0; n < 4; ++n) v[n] = acc[m][n][j] * r;
      const int pos = row < MPR ? (row & 2047) : 2048 + ((row - MPR) & 15);
      const f32x2 cs = ropeT[pos * 16 + fr];
#pragma unroll
      for (int n = 0; n < 4; n += 2) {
        if (((s0 + n) % 6) == 4) {
          const float x1 = v[n], x2 = v[n + 1];
          v[n] = x1 * cs.x - x2 * cs.y;
          v[n + 1] = x2 * cs.x + x1 * cs.y;
        }
      }
#pragma unroll
      for (int n = 0; n < 4; ++n) q[(size_t)row * 768 + nt * 128 + wc * 64 + n * 16 + fr] = f2bf(v[n]);
    }
}

__device__ void kv_tile(const u16* lat, const u16* Wt, u16* Kn, u16* Vtp, u16* Vts, int mt, int nt, bool pre, bool hn,
                        int mt2, int nt2, char* smem) {
  TILE_IDS
  f32x4 acc[4][4];
  ZERO_ACC(acc)
  if (!pre) { __syncthreads(); gemm_first<4>(lat, 256, Wt, 256, mt * 128, nt * 128, smem); }
  gemm_main<4>(lat, 256, Wt, 256, 256, mt * 128, nt * 128, acc, smem, true);
  if (hn) gemm_first<4>(lat, 256, Wt, 256, mt2 * 128, nt2 * 128, smem);
  const int hh = nt;
  if (wc == 0) {
#pragma unroll
    for (int m = 0; m < 4; ++m)
#pragma unroll
      for (int j = 0; j < 4; ++j) {
        const int row = mt * 128 + wr * 64 + m * 16 + fq * 4 + j;
#pragma unroll
        for (int n = 0; n < 4; ++n) Kn[(size_t)row * 512 + hh * 64 + n * 16 + fr] = f2bf(acc[m][n][j]);
      }
  } else {
#pragma unroll
    for (int m = 0; m < 4; ++m) {
      const int row = mt * 128 + wr * 64 + m * 16 + fq * 4;
      u16* base;
      size_t stride;
      int key;
      if (row < MPR) {
        const int b = row >> 11;
        key = row & 2047;
        base = Vtp + (size_t)(b * 8 + hh) * 64 * 2048;
        stride = 2048;
      } else {
        const int r2 = row - MPR;
        const int b = r2 / SKEYS;
        key = r2 - b * SKEYS;
        base = Vts + (size_t)(b * 8 + hh) * 64 * VSTR_S;
        stride = VSTR_S;
      }
#pragma unroll
      for (int n = 0; n < 4; ++n) {
        const int dim = n * 16 + fr;
        *(u32x2*)(base + (size_t)dim * stride + key) = pack4(acc[m][n][0], acc[m][n][1], acc[m][n][2], acc[m][n][3]);
      }
    }
  }
}

__device__ void merge_tile(const u16* abuf, const u16* yb, const u16* yc, const u16* yd, const u16* wa, const u16* wb,
                           const u16* wcc, const u16* wd, const u16* h, u16* mg, int mt, int nt, bool pre, bool hn, int mt2,
                           int nt2, char* smem) {
  TILE_IDS
  f32x4 tot[4][2];
#pragma unroll
  for (int m = 0; m < 4; ++m)
#pragma unroll
    for (int n = 0; n < 2; ++n) tot[m][n] = f32x4{0.f, 0.f, 0.f, 0.f};
  for (int b = 0; b < 4; ++b) {
    f32x4 acc[4][2];
#pragma unroll
    for (int m = 0; m < 4; ++m)
#pragma unroll
      for (int n = 0; n < 2; ++n) acc[m][n] = f32x4{0.f, 0.f, 0.f, 0.f};
    const u16* A = b == 0 ? abuf : (b == 1 ? yb : (b == 2 ? yc : yd));
    const u16* W = b == 0 ? wa : (b == 1 ? wb : (b == 2 ? wcc : wd));
    const int K = b == 0 ? 512 : 256;
    if (b == 0 && !pre) { __syncthreads(); gemm_first<2>(A, K, W, K, mt * 128, nt * 64, smem); }
    u16 gv[4][4][2];
#pragma unroll
    for (int m = 0; m < 4; ++m)
#pragma unroll
      for (int j = 0; j < 4; ++j) {
        const int row = mt * 128 + wr * 64 + m * 16 + fq * 4 + j;
        const u16* gp = h + (size_t)row * HLD + C_GATE + b * 1024 + nt * 64 + wc * 32 + fr;
        gv[m][j][0] = gp[0]; gv[m][j][1] = gp[16];
      }
    gemm_main<2>(A, K, W, K, K, mt * 128, nt * 64, acc, smem, true);
    if (b < 3) {
      const u16* A2 = b == 0 ? yb : (b == 1 ? yc : yd);
      const u16* W2 = b == 0 ? wb : (b == 1 ? wcc : wd);
      gemm_first<2>(A2, 256, W2, 256, mt * 128, nt * 64, smem);
    }
#pragma unroll
    for (int m = 0; m < 4; ++m)
#pragma unroll
      for (int j = 0; j < 4; ++j) {
#pragma unroll
        for (int n = 0; n < 2; ++n) tot[m][n][j] += bf2f(gv[m][j][n]) * acc[m][n][j];
      }
  }
  if (hn) gemm_first<2>(abuf, 512, wa, 512, mt2 * 128, nt2 * 64, smem);
#pragma unroll
  for (int m = 0; m < 4; ++m)
#pragma unroll
    for (int j = 0; j < 4; ++j) {
      const int row = mt * 128 + wr * 64 + m * 16 + fq * 4 + j;
#pragma unroll
      for (int n = 0; n < 2; ++n) mg[(size_t)row * 1024 + nt * 64 + wc * 32 + n * 16 + fr] = f2bf(tot[m][n][j]);
    }
}

__device__ __forceinline__ void conv_load(const float* __restrict__ src, int ld, int nvalid, int mode,
                                          const float* __restrict__ scale, int n0, int k0, float (&v)[16]) {
  const int tid = otid();
  const int nn = tid & 63, kk0 = tid >> 6;
  const int n = n0 + nn;
  int sc = n;
  if (mode == 1) {
    const int G = n >> 4, T = G >> 4, w = (G >> 3) & 1, q = G & 7;
    sc = (q >> 2) * DFF + T * 128 + w * 64 + (q & 3) * 16 + (n & 15);
  }
  const bool valid = n < nvalid;
#pragma unroll
  for (int i = 0; i < 16; ++i) {
    const int kk = kk0 + 4 * i;
    float x = 0.f;
    if (valid) {
      x = src[(size_t)(k0 + kk) * ld + sc];
      if (scale) x *= scale[k0 + kk];
    }
    v[i] = x;
  }
}
__device__ __forceinline__ void conv_commit(const float (&v)[16], u16* __restrict__ dst, int K, int n0, int k0,
                                            char* smem) {
  float* sm = (float*)smem;
  const int tid = otid();
  __syncthreads();
  {
    const int nn = tid & 63, kk0 = tid >> 6;
#pragma unroll
    for (int i = 0; i < 16; ++i) sm[(kk0 + 4 * i) * 65 + nn] = v[i];
  }
  __syncthreads();
  {
    const int c8 = tid & 7;
#pragma unroll
    for (int it = 0; it < 2; ++it) {
      const int nn = (tid >> 3) + 32 * it;
      float f[8];
#pragma unroll
      for (int e = 0; e < 8; ++e) f[e] = sm[(c8 * 8 + e) * 65 + nn];
      u32x4 o;
      o.x = pk2(f[0], f[1]); o.y = pk2(f[2], f[3]); o.z = pk2(f[4], f[5]); o.w = pk2(f[6], f[7]);
      *(u32x4*)(dst + (size_t)(n0 + nn) * K + k0 + c8 * 8) = o;
    }
  }
}

__device__ void convert_layer(const Params& p, int l, char* smem) {
  char* ws = p.ws;
  const int NJ = 12;
  const int jt[NJ + 1] = {0, 1408, 2112, 3776, 3848, 3912, 4040, 4104, 4168, 4232, 4488, 5896, 6600};
  bool havePrev = false;
  float pv[16];
  u16* pdst = nullptr;
  int pK = 0, pn0 = 0, pk0 = 0;
  for (int it = blockIdx.x;; it += gridDim.x) {
    const bool valid = it < 6600;
    float nv[16];
    u16* ndst_p = nullptr;
    int nK = 0, nn0 = 0, nk0 = 0;
    if (valid) {
      int j = 0, jbase = 0;
#pragma unroll
      for (int q = 1; q < NJ; ++q)
        if (it >= jt[q]) { j = q; jbase = jt[q]; }
      const int loc = it - jbase;
      const float* src; int ld, K, nvalid, mode = 0, ndst; u16* dst; const float* scale = nullptr;
      switch (j) {
        case 0: src = p.in[8] + (size_t)l * 1024 * 5632; ld = 5632; K = 1024; ndst = 5632; nvalid = 5632; mode = 1;
                dst = (u16*)(ws + W_GU1); scale = p.in[6] + l * 1024; break;
        case 1: src = p.in[9] + (size_t)l * 2816 * 1024; ld = 1024; K = 2816; ndst = 1024; nvalid = 1024;
                dst = (u16*)(ws + W_D1); break;
        case 2: src = p.in[12] + (size_t)l * 1024 * DIN; ld = DIN; K = 1024; ndst = HLD; nvalid = DIN;
                dst = (u16*)(ws + W_IN); scale = p.in[10] + l * 1024; break;
        case 3: src = p.in[14] + (size_t)l * 384 * 768; ld = 768; K = 384; ndst = 768; nvalid = 768;
                dst = (u16*)(ws + W_UQ); scale = p.in[13] + l * 384; break;
        case 4: src = p.in[16] + (size_t)l * 256 * 1024; ld = 1024; K = 256; ndst = 1024; nvalid = 1024;
                dst = (u16*)(ws + W_UKV); break;
        case 5: src = p.in[26] + (size_t)l * 512 * 1024; ld = 1024; K = 512; ndst = 1024; nvalid = 1024;
                dst = (u16*)(ws + W_BRA); break;
        case 6: src = p.in[27] + (size_t)l * 256 * 1024; ld = 1024; K = 256; ndst = 1024; nvalid = 1024;
                dst = (u16*)(ws + W_BRB); break;
        case 7: src = p.in[28] + (size_t)l * 256 * 1024; ld = 1024; K = 256; ndst = 1024; nvalid = 1024;
                dst = (u16*)(ws + W_BRC); break;
        case 8: src = p.in[29] + (size_t)l * 256 * 1024; ld = 1024; K = 256; ndst = 1024; nvalid = 1024;
                dst = (u16*)(ws + W_BRD); break;
        case 9: src = p.in[30] + (size_t)l * 1024 * 1024; ld = 1024; K = 1024; ndst = 1024; nvalid = 1024;
                dst = (u16*)(ws + W_O); break;
        case 10: src = p.in[33] + (size_t)l * 1024 * 5632; ld = 5632; K = 1024; ndst = 5632; nvalid = 5632; mode = 1;
                dst = (u16*)(ws + W_GU2); scale = p.in[31] + l * 1024; break;
        default: src = p.in[34] + (size_t)l * 2816 * 1024; ld = 1024; K = 2816; ndst = 1024; nvalid = 1024;
                dst = (u16*)(ws + W_D2); break;
      }
      const int ntn = ndst >> 6;
      nn0 = (loc % ntn) * 64; nk0 = (loc / ntn) * 64; nK = K; ndst_p = dst;
      conv_load(src, ld, nvalid, mode, scale, nn0, nk0, nv);
    }
    if (havePrev) conv_commit(pv, pdst, pK, pn0, pk0, smem);
    if (!valid) break;
#pragma unroll
    for (int q = 0; q < 16; ++q) pv[q] = nv[q];
    pdst = ndst_p; pK = nK; pn0 = nn0; pk0 = nk0; havePrev = true;
  }
  for (int it = 6600 + blockIdx.x; it < 6600 + 288; it += gridDim.x) {
    {
      const int ci = it - 6600;
      const int tid = otid();
      if (ci < 256) {
        const float* src = p.in[2] + (size_t)l * 8 * 2048 * 256;
        u16* dst = (u16*)(ws + B_LAT) + (size_t)MPR * 256;
#pragma unroll 2
        for (int i = 0; i < 8; ++i) {
          const size_t ch = (size_t)ci * 2048 + i * 256 + tid;
          const size_t e = ch * 8;
          const int b = (int)(e / (2048 * 256));
          const size_t within = e - (size_t)b * 2048 * 256;
          const f32x4 v0 = *(const f32x4*)(src + e), v1 = *(const f32x4*)(src + e + 4);
          u32x4 o;
          o.x = pk2(v0.x, v0.y); o.y = pk2(v0.z, v0.w); o.z = pk2(v1.x, v1.y); o.w = pk2(v1.z, v1.w);
          *(u32x4*)(dst + (size_t)b * SKEYS * 256 + within) = o;
        }
      } else {
        const int c2 = ci - 256;
        const float* src = p.in[3] + (size_t)l * 8 * 2048 * 32;
        u16* dst = (u16*)(ws + B_KR) + (size_t)MPR * 32;
#pragma unroll 2
        for (int i = 0; i < 8; ++i) {
          const size_t ch = (size_t)c2 * 2048 + i * 256 + tid;
          const size_t e = ch * 8;
          const int b = (int)(e / (2048 * 32));
          const size_t within = e - (size_t)b * 2048 * 32;
          const f32x4 v0 = *(const f32x4*)(src + e), v1 = *(const f32x4*)(src + e + 4);
          u32x4 o;
          o.x = pk2(v0.x, v0.y); o.y = pk2(v0.z, v0.w); o.z = pk2(v1.x, v1.y); o.w = pk2(v1.z, v1.w);
          *(u32x4*)(dst + (size_t)b * SKEYS * 32 + within) = o;
        }
      }
    }
  }
}

__device__ void row_update(const Params& p, int mode, float alpha, const float* g, bool finalw) {
  const int lane = otid() & 63, wid = otid() >> 6;
  float* x = p.out;
  const float* y = (const float*)(p.ws + B_Y);
  u16* xb = (u16*)(p.ws + B_XB);
  float* rsx = (float*)(p.ws + B_RSX);
  const int stride = gridDim.x * 4;
  int row = blockIdx.x * 4 + wid;
  if (row >= MROWS) return;
  f32x4 xv[4], yv[4], gv[4];
  if (mode == 0) {
#pragma unroll
    for (int i = 0; i < 4; ++i) { yv[i] = f32x4{0.f, 0.f, 0.f, 0.f}; gv[i] = f32x4{0.f, 0.f, 0.f, 0.f}; }
  } else {
#pragma unroll
    for (int i = 0; i < 4; ++i) gv[i] = *(const f32x4*)(g + i * 256 + lane * 4);
  }
  auto load_row = [&](int r, f32x4 (&xr)[4], f32x4 (&yr)[4]) {
    if (mode == 0) {
      const float* src = r < MPR ? p.in[0] + (size_t)r * 1024 : p.in[1] + (size_t)(r - MPR) * 1024;
#pragma unroll
      for (int i = 0; i < 4; ++i) xr[i] = *(const f32x4*)(src + i * 256 + lane * 4);
    } else {
#pragma unroll
      for (int i = 0; i < 4; ++i) {
        yr[i] = *(const f32x4*)(y + (size_t)r * 1024 + i * 256 + lane * 4);
        {
          float t_[4];
          unpack4(*(const u32x2*)(xb + (size_t)r * 1024 + i * 256 + lane * 4), t_);
          xr[i] = f32x4{t_[0], t_[1], t_[2], t_[3]};
        }
      }
    }
  };
  load_row(row, xv, yv);
  for (;;) {
    const int nrow = row + stride;
    const bool hn = nrow < MROWS;
    f32x4 xn[4], yn[4];
#pragma unroll
    for (int i = 0; i < 4; ++i) { xn[i] = f32x4{0.f, 0.f, 0.f, 0.f}; yn[i] = f32x4{0.f, 0.f, 0.f, 0.f}; }
    if (hn) load_row(nrow, xn, yn);
    if (mode != 0) {
      float ss = 0.f;
#pragma unroll
      for (int i = 0; i < 4; ++i)
        ss += yv[i].x * yv[i].x + yv[i].y * yv[i].y + yv[i].z * yv[i].z + yv[i].w * yv[i].w;
      ss = wave_sum(ss);
      const float r = rsqrtf(ss * (1.f / 1024.f) + EPSV) * alpha;
#pragma unroll
      for (int i = 0; i < 4; ++i) {
        xv[i].x += yv[i].x * r * gv[i].x; xv[i].y += yv[i].y * r * gv[i].y;
        xv[i].z += yv[i].z * r * gv[i].z; xv[i].w += yv[i].w * r * gv[i].w;
      }
    }
    float s2 = 0.f;
#pragma unroll
    for (int i = 0; i < 4; ++i) {
      s2 += xv[i].x * xv[i].x + xv[i].y * xv[i].y + xv[i].z * xv[i].z + xv[i].w * xv[i].w;
      if (finalw) *(f32x4*)(x + (size_t)row * 1024 + i * 256 + lane * 4) = xv[i];
      *(u32x2*)(xb + (size_t)row * 1024 + i * 256 + lane * 4) = pack4(xv[i].x, xv[i].y, xv[i].z, xv[i].w);
    }
    s2 = wave_sum(s2);
    if (lane == 0) rsx[row] = rsqrtf(s2 * (1.f / 1024.f) + EPSV);
    if (!hn) break;
    row = nrow;
#pragma unroll
    for (int i = 0; i < 4; ++i) { xv[i] = xn[i]; yv[i] = yn[i]; }
  }
}

__device__ void row_prep(const Params& p, int l) {
  const int lane = otid() & 63, wid = otid() >> 6;
  char* ws = p.ws;
  u16* h = (u16*)(ws + B_BIG);
  float* rsq = (float*)(ws + B_RSQ);
  const f32x2* ropeT = (const f32x2*)(ws + B_ROPE);
  u16* lat = (u16*)(ws + B_LAT);
  u16* kra = (u16*)(ws + B_KR);
  float* out = p.out;
  for (int row = blockIdx.x * 4 + wid; row < MROWS; row += gridDim.x * 4) {
    u16* hr = h + (size_t)row * HLD;
    const bool smp = row >= MPR;
    int b, t, pos;
    size_t latrow;
    if (!smp) { b = row >> 11; t = row & 2047; pos = t; latrow = row; }
    else { const int r2 = row - MPR; b = r2 >> 4; t = r2 & 15; pos = 2048 + t; latrow = (size_t)MPR + (size_t)b * SKEYS + 2048 + t; }
    const int lb = l * 8 + b;
    u32x4 ld_cq = u32x4{0u, 0u, 0u, 0u};
    if (lane < 48) ld_cq = *(const u32x4*)(hr + C_CQ + lane * 8);
    const u32x2 ld_kv = *(const u32x2*)(hr + C_KV + lane * 4);
    u16 ld_k1 = 0, ld_k2 = 0;
    if (lane < 16) { ld_k1 = hr[C_KR + lane]; ld_k2 = hr[C_KR + 16 + lane]; }
    const u32x2 ld_ga = *(const u32x2*)(hr + C_GA + lane * 4);
    const u32x2 ld_gg = *(const u32x2*)(hr + C_GG + lane * 4);
    const u32x2 ld_v = *(const u32x2*)(hr + C_V + lane * 4);
    const u32x2 ld_cg = *(const u32x2*)(hr + C_CG + lane * 4);
    const u32x2 ld_hd = *(const u32x2*)(hr + C_HD + lane * 4);
    {
      float ss = 0.f;
      if (lane < 48) {
        const u32x4 v = ld_cq;
        float f[4];
        unpack4(u32x2{v.x, v.y}, f); ss += f[0] * f[0] + f[1] * f[1] + f[2] * f[2] + f[3] * f[3];
        unpack4(u32x2{v.z, v.w}, f); ss += f[0] * f[0] + f[1] * f[1] + f[2] * f[2] + f[3] * f[3];
      }
      ss = wave_sum(ss);
      if (lane == 0) rsq[row] = rsqrtf(ss * (1.f / 384.f) + EPSV);
    }
    {
      float f[4];
      unpack4(ld_kv, f);
      float ss = wave_sum(f[0] * f[0] + f[1] * f[1] + f[2] * f[2] + f[3] * f[3]);
      const float r = rsqrtf(ss * (1.f / 256.f) + EPSV);
      const f32x4 g = *(const f32x4*)(p.in[15] + l * 256 + lane * 4);
      f32x4 o;
      o.x = f[0] * r * g.x; o.y = f[1] * r * g.y; o.z = f[2] * r * g.z; o.w = f[3] * r * g.w;
      float* op = smp ? out + O_LATS + ((size_t)lb * 16 + t) * 256 : out + O_LATP + ((size_t)lb * 2048 + t) * 256;
      *(f32x4*)(op + lane * 4) = o;
      *(u32x2*)(lat + latrow * 256 + lane * 4) = pack4(o.x, o.y, o.z, o.w);
    }
    if (lane < 16) {
      const float x1 = bf2f(ld_k1), x2 = bf2f(ld_k2);
      const f32x2 cs = ropeT[pos * 16 + lane];
      const float o1 = x1 * cs.x - x2 * cs.y, o2 = x2 * cs.x + x1 * cs.y;
      float* op = smp ? out + O_KRS + ((size_t)lb * 16 + t) * 32 : out + O_KRP + ((size_t)lb * 2048 + t) * 32;
      op[lane] = o1; op[lane + 16] = o2;
      kra[latrow * 32 + lane] = f2bf(o1);
      kra[latrow * 32 + 16 + lane] = f2bf(o2);
    }
    {
      float a[4], gg[4];
      unpack4(ld_ga, a);
      unpack4(ld_gg, gg);
      f32x4 o;
      o.x = a[0] * sigm(gg[0]); o.y = a[1] * sigm(gg[1]); o.z = a[2] * sigm(gg[2]); o.w = a[3] * sigm(gg[3]);
      *(u32x2*)(hr + C_GA + lane * 4) = pack4(o.x, o.y, o.z, o.w);
      if (!smp) {
        if (t >= 2018) *(f32x4*)(out + O_CBP + ((size_t)lb * 30 + (t - 2018)) * 256 + lane * 4) = o;
      } else {
        *(f32x4*)(out + O_CBS + ((size_t)lb * 30 + 14 + t) * 256 + lane * 4) = o;
        if (t < 14)
          *(f32x4*)(out + O_CBS + ((size_t)lb * 30 + t) * 256 + lane * 4) =
              *(const f32x4*)(p.in[4] + ((size_t)lb * 30 + 16 + t) * 256 + lane * 4);
      }
    }
    {
      float f[4];
      unpack4(ld_v, f);
      const float mean = wave_sum(f[0] + f[1] + f[2] + f[3]) * (1.f / 256.f);
      const float d0 = f[0] - mean, d1 = f[1] - mean, d2 = f[2] - mean, d3 = f[3] - mean;
      const float var = wave_sum(d0 * d0 + d1 * d1 + d2 * d2 + d3 * d3) * (1.f / 256.f);
      const float r = rsqrtf(var + EPSV);
      const f32x4 g = *(const f32x4*)(p.in[21] + l * 256 + lane * 4);
      const f32x4 bb = *(const f32x4*)(p.in[22] + l * 256 + lane * 4);
      f32x4 o;
      o.x = d0 * r * g.x + bb.x; o.y = d1 * r * g.y + bb.y; o.z = d2 * r * g.z + bb.z; o.w = d3 * r * g.w + bb.w;
      *(u32x2*)(hr + C_V + lane * 4) = pack4(o.x, o.y, o.z, o.w);
      if (smp) *(f32x4*)(out + O_VS + ((size_t)lb * 16 + t) * 256 + lane * 4) = o;
    }
    {
      float c[4], hd[4];
      unpack4(ld_cg, c);
      unpack4(ld_hd, hd);
      f32x4 o;
      o.x = c[0] * hd[0]; o.y = c[1] * hd[1]; o.z = c[2] * hd[2]; o.w = c[3] * hd[3];
      *(u32x2*)(hr + C_CG + lane * 4) = pack4(o.x, o.y, o.z, o.w);
      if (!smp) {
        if (t >= 2046) *(f32x4*)(out + O_CDP + ((size_t)lb * 2 + (t - 2046)) * 256 + lane * 4) = o;
      } else {
        if (t >= 14) *(f32x4*)(out + O_CDS + ((size_t)lb * 2 + (t - 14)) * 256 + lane * 4) = o;
      }
    }
  }
}

__device__ void conv_item(const Params& p, int l, int item, char* smem) {
  const int tid = otid(), lane = tid & 63, wid = tid >> 6;
  char* ws = p.ws;
  const u16* h = (const u16*)(ws + B_BIG);
  u16* ybp = (u16*)(ws + B_YB);
  u16* ydp = (u16*)(ws + B_YD);
  u16* X = (u16*)smem;
  float* Wc = (float*)(smem + 31744);
  const bool smp = item >= 512;
  int b, t0;
  size_t R0;
  if (!smp) { b = item >> 6; t0 = (item & 63) * 32; R0 = (size_t)b * 2048; }
  else { b = item - 512; t0 = 0; R0 = (size_t)MPR + b * 16; }
  const int lb = l * 8 + b;
  __syncthreads();
  {
    u32x4 xv[8];
    f32x4 wv[8];
    const f32x4* wsrc = (const f32x4*)(p.in[17] + (size_t)l * 31 * 256);
#pragma unroll
    for (int it = 0; it < 8; ++it) {
      const int ch = tid + 256 * it;
      const int i = ch >> 5, c8 = ch & 31;
      const int tt = t0 - 30 + i;
      u32x4 v = u32x4{0u, 0u, 0u, 0u};
      if (ch < 62 * 32) {
        if (!smp) {
          if (tt >= 0) v = *(const u32x4*)(h + (R0 + tt) * HLD + C_GA + c8 * 8);
        } else {
          if (tt < 0) {
            const float* sp = p.in[4] + ((size_t)lb * 30 + (30 + tt)) * 256 + c8 * 8;
            const f32x4 v0 = *(const f32x4*)sp, v1 = *(const f32x4*)(sp + 4);
            v.x = pk2(v0.x, v0.y); v.y = pk2(v0.z, v0.w); v.z = pk2(v1.x, v1.y); v.w = pk2(v1.z, v1.w);
          } else if (tt < 16) {
            v = *(const u32x4*)(h + (R0 + tt) * HLD + C_GA + c8 * 8);
          }
        }
      }
      xv[it] = v;
      wv[it] = ch < 1984 ? wsrc[ch] : f32x4{0.f, 0.f, 0.f, 0.f};
    }
#pragma unroll
    for (int it = 0; it < 8; ++it) {
      const int ch = tid + 256 * it;
      if (ch < 62 * 32) {
        *(u32x4*)(X + (ch >> 5) * 256 + (ch & 31) * 8) = xv[it];
        ((f32x4*)Wc)[ch] = wv[it];
      }
    }
  }
  __syncthreads();
  if (!smp || wid < 2) {
    const int tr0 = wid * 8;
    float acc[8][4];
    {
      const f32x4 bi = *(const f32x4*)(p.in[18] + l * 256 + lane * 4);
#pragma unroll
      for (int r = 0; r < 8; ++r) { acc[r][0] = bi.x; acc[r][1] = bi.y; acc[r][2] = bi.z; acc[r][3] = bi.w; }
    }
    {
      const f32x4 dw0 = *(const f32x4*)(p.in[25] + (size_t)l * 768 + lane * 4);
      const f32x4 dw1 = *(const f32x4*)(p.in[25] + (size_t)l * 768 + 256 + lane * 4);
      const f32x4 dw2 = *(const f32x4*)(p.in[25] + (size_t)l * 768 + 512 + lane * 4);
      float xf[10][4];
      u32x2 bgv[8];
#pragma unroll
      for (int q = 0; q < 10; ++q) {
        const int tq = t0 + tr0 + q - 2;
        if (tq >= 0) {
          unpack4(*(const u32x2*)(h + (R0 + tq) * HLD + C_CG + lane * 4), xf[q]);
        } else if (smp) {
          const f32x4 sv = *(const f32x4*)(p.in[5] + ((size_t)lb * 2 + (2 + tq)) * 256 + lane * 4);
          xf[q][0] = sv.x; xf[q][1] = sv.y; xf[q][2] = sv.z; xf[q][3] = sv.w;
        } else {
          xf[q][0] = xf[q][1] = xf[q][2] = xf[q][3] = 0.f;
        }
      }
#pragma unroll
      for (int r = 0; r < 8; ++r) bgv[r] = *(const u32x2*)(h + (R0 + t0 + tr0 + r) * HLD + C_BG + lane * 4);
#pragma unroll
      for (int r = 0; r < 8; ++r) {
        float bg[4];
        unpack4(bgv[r], bg);
        const float z0 = bg[0] * (dw2.x * xf[r + 2][0] + dw1.x * xf[r + 1][0] + dw0.x * xf[r][0]);
        const float z1 = bg[1] * (dw2.y * xf[r + 2][1] + dw1.y * xf[r + 1][1] + dw0.y * xf[r][1]);
        const float z2 = bg[2] * (dw2.z * xf[r + 2][2] + dw1.z * xf[r + 1][2] + dw0.z * xf[r][2]);
        const float z3 = bg[3] * (dw2.w * xf[r + 2][3] + dw1.w * xf[r + 1][3] + dw0.w * xf[r][3]);
        *(u32x2*)(ydp + (R0 + t0 + tr0 + r) * 256 + lane * 4) = pack4(z0, z1, z2, z3);
      }
    }
    for (int k = 0; k < 31; ++k) {
      const f32x4 w4 = *(const f32x4*)(Wc + k * 256 + lane * 4);
#pragma unroll
      for (int r = 0; r < 8; ++r) {
        float xv[4];
        unpack4(*(const u32x2*)(X + (tr0 + r + k) * 256 + lane * 4), xv);
        acc[r][0] += w4.x * xv[0]; acc[r][1] += w4.y * xv[1]; acc[r][2] += w4.z * xv[2]; acc[r][3] += w4.w * xv[3];
      }
    }
    const f32x4 lg = *(const f32x4*)(p.in[19] + l * 256 + lane * 4);
    const f32x4 lbb = *(const f32x4*)(p.in[20] + l * 256 + lane * 4);
#pragma unroll
    for (int r = 0; r < 8; ++r) {
      const int t = t0 + tr0 + r;
      const size_t row = R0 + t;
      const float mean = wave_sum(acc[r][0] + acc[r][1] + acc[r][2] + acc[r][3]) * (1.f / 256.f);
      const float d0 = acc[r][0] - mean, d1 = acc[r][1] - mean, d2 = acc[r][2] - mean, d3 = acc[r][3] - mean;
      const float var = wave_sum(d0 * d0 + d1 * d1 + d2 * d2 + d3 * d3) * (1.f / 256.f);
      const float rs = rsqrtf(var + EPSV);
      float y0 = d0 * rs * lg.x + lbb.x, y1 = d1 * rs * lg.y + lbb.y, y2 = d2 * rs * lg.z + lbb.z,
            y3 = d3 * rs * lg.w + lbb.w;
      y0 *= sigm(y0); y1 *= sigm(y1); y2 *= sigm(y2); y3 *= sigm(y3);
      *(u32x2*)(ybp + row * 256 + lane * 4) = pack4(y0, y1, y2, y3);
    }
  }
}

__device__ void gmlp_item(const Params& p, int l, int item, char* smem) {
  const int tid = otid(), lane = tid & 63, wid = tid >> 6, fr = lane & 15, fq = lane >> 4;
  char* ws = p.ws;
  const u16* h = (const u16*)(ws + B_BIG);
  u16* ycp = (u16*)(ws + B_YC);
  u16* vT = (u16*)smem;
  int b, g, nrows;
  size_t R0;
  if (item < 512) { b = item >> 6; const int n = (item >> 2) & 15; g = item & 3; R0 = (size_t)b * 2048 + n * 128; nrows = 128; }
  else { const int i2 = item - 512; b = i2 >> 2; g = i2 & 3; R0 = (size_t)MPR + b * 16; nrows = 16; }
  const float* Wg = p.in[23] + (size_t)(l * 4 + g) * 16384;
  const float* bs = p.in[24] + (size_t)(l * 4 + g) * 128;
  u32x4 fv[4];
#pragma unroll
  for (int it = 0; it < 4; ++it) {
    const int ch = tid + 256 * it, j = ch >> 3, c8 = ch & 7;
    fv[it] = u32x4{0u, 0u, 0u, 0u};
    if (j < nrows) fv[it] = *(const u32x4*)(h + (R0 + j) * HLD + C_V + g * 64 + c8 * 8);
  }
  f32x4 wq[2][4][2];
  float bsv[2][4];
  u16 uu[2][4][4];
#pragma unroll
  for (int mm = 0; mm < 2; ++mm) {
    const int m = wid * 2 + mm;
    const int kmax = (m * 16 < nrows) ? ((nrows == 16) ? 1 : (m < 4 ? 2 : 4)) : 0;
#pragma unroll
    for (int ks = 0; ks < 4; ++ks) {
      wq[mm][ks][0] = f32x4{0.f, 0.f, 0.f, 0.f};
      wq[mm][ks][1] = f32x4{0.f, 0.f, 0.f, 0.f};
      if (ks < kmax) {
        const float* wp = Wg + (size_t)(m * 16 + fr) * 128 + ks * 32 + fq * 8;
        wq[mm][ks][0] = *(const f32x4*)wp;
        wq[mm][ks][1] = *(const f32x4*)(wp + 4);
      }
    }
#pragma unroll
    for (int j = 0; j < 4; ++j) {
      const int i = m * 16 + fq * 4 + j;
      bsv[mm][j] = 0.f;
#pragma unroll
      for (int n = 0; n < 4; ++n) uu[mm][j][n] = 0;
      if (i < nrows) {
        bsv[mm][j] = bs[i];
#pragma unroll
        for (int n = 0; n < 4; ++n) uu[mm][j][n] = h[(R0 + i) * HLD + C_U + g * 64 + n * 16 + fr];
      }
    }
  }
  __syncthreads();
#pragma unroll
  for (int it = 0; it < 4; ++it) {
    const int ch = tid + 256 * it, j = ch >> 3, c8 = ch & 7;
    const u32x4 v = fv[it];
    u16* d = vT + (c8 * 8) * 136 + j;
    d[0 * 136] = (u16)(v.x & 0xffff); d[1 * 136] = (u16)(v.x >> 16);
    d[2 * 136] = (u16)(v.y & 0xffff); d[3 * 136] = (u16)(v.y >> 16);
    d[4 * 136] = (u16)(v.z & 0xffff); d[5 * 136] = (u16)(v.z >> 16);
    d[6 * 136] = (u16)(v.w & 0xffff); d[7 * 136] = (u16)(v.w >> 16);
  }
  __syncthreads();
  f32x4 acc[2][4];
#pragma unroll
  for (int mm = 0; mm < 2; ++mm)
#pragma unroll
    for (int n = 0; n < 4; ++n) acc[mm][n] = f32x4{0.f, 0.f, 0.f, 0.f};
#pragma unroll
  for (int mm = 0; mm < 2; ++mm) {
    const int m = wid * 2 + mm;
    if (m * 16 < nrows) {
      const int kmax = (nrows == 16) ? 1 : (m < 4 ? 2 : 4);
#pragma unroll
      for (int ks = 0; ks < 4; ++ks) {
        if (ks < kmax) {
          const f32x4 w0 = wq[mm][ks][0], w1 = wq[mm][ks][1];
          union { u32x4 u; bf16x8 v; } cv;
          cv.u.x = pk2(w0.x, w0.y); cv.u.y = pk2(w0.z, w0.w); cv.u.z = pk2(w1.x, w1.y); cv.u.w = pk2(w1.z, w1.w);
#pragma unroll
          for (int n = 0; n < 4; ++n) {
            const bf16x8 bv = *(const bf16x8*)(vT + (n * 16 + fr) * 136 + ks * 32 + fq * 8);
            acc[mm][n] = MFMA16(cv.v, bv, acc[mm][n]);
          }
        }
      }
    }
  }
#pragma unroll
  for (int mm = 0; mm < 2; ++mm) {
    const int m = wid * 2 + mm;
#pragma unroll
    for (int j = 0; j < 4; ++j) {
      const int i = m * 16 + fq * 4 + j;
      if (i < nrows) {
#pragma unroll
        for (int n = 0; n < 4; ++n) {
          const int c = g * 64 + n * 16 + fr;
          ycp[(R0 + i) * 256 + c] = f2bf(bf2f(uu[mm][j][n]) * (acc[mm][n][j] + bsv[mm][j]));
        }
      }
    }
  }
}

__device__ void attn_item(const Params& p, int idx, char* smem) {
  const int tid = otid(), lane = tid & 63, wid = tid >> 6, fr = lane & 15, fq = lane >> 4;
  char* ws = p.ws;
  const u16* qb = (const u16*)(ws + B_Q);
  const u16* Kn = (const u16*)(ws + B_KN);
  const u16* kra = (const u16*)(ws + B_KR);
  u16* ab = (u16*)(ws + B_A);
  int hh, ntiles, myt, nkeys, vstride;
  size_t qrow[2], krow0;
  const u16* Vp;
  const bool smp = idx < 64;
  if (smp) {
    const int b = idx >> 3; hh = idx & 7; ntiles = 33; myt = 33; nkeys = SKEYS; vstride = VSTR_S;
    qrow[0] = qrow[1] = (size_t)MPR + b * 16 + fr; krow0 = (size_t)MPR + (size_t)b * SKEYS;
    Vp = (const u16*)(ws + B_VTS) + (size_t)(b * 8 + hh) * 64 * VSTR_S;
  } else {
    const int i = idx - 64; const int pp = 15 - (i >> 6); const int b = (i & 63) >> 3; hh = i & 7;
    ntiles = 2 * pp + 2; myt = 2 * pp + 1 + (wid >> 1); nkeys = 2048; vstride = 2048;
    qrow[0] = (size_t)b * 2048 + pp * 128 + wid * 32 + fr; qrow[1] = qrow[0] + 16; krow0 = (size_t)b * 2048;
    Vp = (const u16*)(ws + B_VTP) + (size_t)(b * 8 + hh) * 64 * 2048;
  }
  const u16* Kp = Kn + krow0 * 512 + hh * 64;
  const u16* KRp = kra + krow0 * 32;
  bf16x8 qf[2][3];
#pragma unroll
  for (int qs = 0; qs < 2; ++qs)
#pragma unroll
    for (int ks = 0; ks < 3; ++ks) qf[qs][ks] = *(const bf16x8*)(qb + qrow[qs] * 768 + hh * 96 + ks * 32 + fq * 8);
  char* Ks = smem;
  char* Vs = smem + 26624;
  const u32x4 z4 = u32x4{0u, 0u, 0u, 0u};
  u32x4 rk[2], rr, rv[2];
#define ATT_LOAD(kt)                                                                                   \
  {                                                                                                    \
    _Pragma("unroll") for (int i = 0; i < 2; ++i) {                                                    \
      const int ch = tid + 256 * i; const int key = (kt) * 64 + (ch >> 3), c8 = ch & 7;                \
      rk[i] = key < nkeys ? *(const u32x4*)(Kp + (size_t)key * 512 + c8 * 8) : z4;                     \
      const int dim = ch >> 3; const int k0 = (kt) * 64 + c8 * 8;                                      \
      rv[i] = k0 < nkeys ? *(const u32x4*)(Vp + (size_t)dim * vstride + k0) : z4;                      \
    }                                                                                                  \
    { const int key = (kt) * 64 + (tid >> 2), c4 = tid & 3;                                            \
      rr = key < nkeys ? *(const u32x4*)(KRp + (size_t)key * 32 + c4 * 8) : z4; }                      \
  }
#define ATT_STORE(buf)                                                                                 \
  {                                                                                                    \
    _Pragma("unroll") for (int i = 0; i < 2; ++i) {                                                    \
      const int ch = tid + 256 * i;                                                                    \
      *(u32x4*)(Ks + (buf) * 13312 + (ch >> 3) * 208 + (ch & 7) * 16) = rk[i];                         \
      *(u32x4*)(Vs + (buf) * 9216 + (ch >> 3) * 144 + (ch & 7) * 16) = rv[i];                          \
    }                                                                                                  \
    *(u32x4*)(Ks + (buf) * 13312 + (tid >> 2) * 208 + 128 + (tid & 3) * 16) = rr;                      \
  }
  ATT_LOAD(0)
  __syncthreads();
  ATT_STORE(0)
  __syncthreads();
  f32x4 o[2][4];
#pragma unroll
  for (int qs = 0; qs < 2; ++qs)
#pragma unroll
    for (int n = 0; n < 4; ++n) o[qs][n] = f32x4{0.f, 0.f, 0.f, 0.f};
  float mrun[2] = {-1e30f, -1e30f}, lrun[2] = {0.f, 0.f};
  for (int kt = 0; kt < ntiles; ++kt) {
    const int cur = kt & 1;
    if (kt + 1 < ntiles) ATT_LOAD(kt + 1)
    if (kt < myt) {
      f32x4 s[2][4];
      const char* kb = Ks + cur * 13312 + fr * 208 + fq * 16;
#pragma unroll
      for (int t = 0; t < 4; ++t) {
        s[0][t] = f32x4{0.f, 0.f, 0.f, 0.f};
        s[1][t] = f32x4{0.f, 0.f, 0.f, 0.f};
#pragma unroll
        for (int ks = 0; ks < 3; ++ks) {
          const bf16x8 a = *(const bf16x8*)(kb + t * 16 * 208 + ks * 64);
          s[0][t] = MFMA16(a, qf[0][ks], s[0][t]);
          s[1][t] = MFMA16(a, qf[1][ks], s[1][t]);
        }
      }
      if (kt * 64 + 64 > nkeys) {
#pragma unroll
        for (int t = 0; t < 4; ++t)
#pragma unroll
          for (int j = 0; j < 4; ++j)
            if (kt * 64 + t * 16 + fq * 4 + j >= nkeys) { s[0][t][j] = -1e30f; s[1][t][j] = -1e30f; }
      }
      bf16x8 pb[2][2];
#pragma unroll
      for (int qs = 0; qs < 2; ++qs) {
        float mx = s[qs][0][0];
#pragma unroll
        for (int t = 0; t < 4; ++t)
#pragma unroll
          for (int j = 0; j < 4; ++j) mx = fmaxf(mx, s[qs][t][j]);
        mx = fmaxf(mx, __shfl_xor(mx, 16, 64));
        mx = fmaxf(mx, __shfl_xor(mx, 32, 64));
        const float mnew = fmaxf(mrun[qs], mx);
        const float alpha = __builtin_amdgcn_exp2f(mrun[qs] - mnew);
        mrun[qs] = mnew;
        float psum = 0.f;
#pragma unroll
        for (int t = 0; t < 4; ++t)
#pragma unroll
          for (int j = 0; j < 4; ++j) {
            const float pv = __builtin_amdgcn_exp2f(s[qs][t][j] - mnew);
            s[qs][t][j] = pv;
            psum += pv;
          }
        lrun[qs] = lrun[qs] * alpha + psum;
#pragma unroll
        for (int n = 0; n < 4; ++n) {
          o[qs][n][0] *= alpha; o[qs][n][1] *= alpha; o[qs][n][2] *= alpha; o[qs][n][3] *= alpha;
        }
#pragma unroll
        for (int s2 = 0; s2 < 2; ++s2) {
          union { u32x4 u; bf16x8 v; } cv;
          cv.u.x = pk2(s[qs][2 * s2][0], s[qs][2 * s2][1]); cv.u.y = pk2(s[qs][2 * s2][2], s[qs][2 * s2][3]);
          cv.u.z = pk2(s[qs][2 * s2 + 1][0], s[qs][2 * s2 + 1][1]);
          cv.u.w = pk2(s[qs][2 * s2 + 1][2], s[qs][2 * s2 + 1][3]);
          pb[qs][s2] = cv.v;
        }
      }
      const char* vb = Vs + cur * 9216 + fr * 144 + fq * 8;
#pragma unroll
      for (int n = 0; n < 4; ++n)
#pragma unroll
        for (int s2 = 0; s2 < 2; ++s2) {
          const u32x2 lo = *(const u32x2*)(vb + n * 16 * 144 + s2 * 64);
          const u32x2 hi = *(const u32x2*)(vb + n * 16 * 144 + s2 * 64 + 32);
          union { u32x4 u; bf16x8 v; } cv;
          cv.u.x = lo.x; cv.u.y = lo.y; cv.u.z = hi.x; cv.u.w = hi.y;
          o[0][n] = MFMA16(cv.v, pb[0][s2], o[0][n]);
          o[1][n] = MFMA16(cv.v, pb[1][s2], o[1][n]);
        }
    }
    if (kt + 1 < ntiles) ATT_STORE(cur ^ 1)
    __syncthreads();
  }
#pragma unroll
  for (int qs = 0; qs < 2; ++qs) {
    float lr = lrun[qs];
    lr += __shfl_xor(lr, 16, 64);
    lr += __shfl_xor(lr, 32, 64);
    const float inv = 1.f / lr;
    if (!smp || (wid == 0 && qs == 0)) {
#pragma unroll
      for (int n = 0; n < 4; ++n)
        *(u32x2*)(ab + qrow[qs] * 512 + hh * 64 + n * 16 + fq * 4) =
            pack4(o[qs][n][0] * inv, o[qs][n][1] * inv, o[qs][n][2] * inv, o[qs][n][3] * inv);
    }
  }
#undef ATT_LOAD
#undef ATT_STORE
}

__device__ void run_phase(const Params& p, int ph, char* smem, int* s_item, int rep) {
  char* ws = p.ws;
  const int nb = gridDim.x, bid = blockIdx.x;
  if (ph == 0 && PM(13)) {
    for (int i = bid * 256 + otid(); i < 2064 * 16; i += nb * 256) {
      const int pos = i >> 4, j = i & 15;
      const float inv = expf(-logf(10000.0f) * (float)j / 16.0f);
      const float ang = (float)pos * inv;
      float sn, cs;
      sincosf(ang, &sn, &cs);
      ((f32x2*)(ws + B_ROPE))[i] = f32x2{cs, sn};
    }
    if (bid == 0 && otid() < 64) ((int*)(ws + B_CNT))[otid()] = 0;
    if (bid == 0) for (int i = otid(); i < XCD_BAR_WORDS; i += 256) ((unsigned*)(ws + B_BAR))[i] = 0u;
    row_update(p, 0, 0.f, nullptr, false);
    convert_layer(p, 0, smem);
    return;
  }
  const int l = (ph - 1) / 13, st = (ph - 1) % 13;
  const u16* xb = (const u16*)(ws + B_XB);
  const float* rsx = (const float*)(ws + B_RSX);
  u16* big = (u16*)(ws + B_BIG);
  float* y = (float*)(ws + B_Y);
  switch (st) {
    case 0:
    case 10: if (PM(0)) {
      const u16* W = (const u16*)(ws + (st == 0 ? W_GU1 : W_GU2));
      zero_y_sample(y);
      ffn_up_phase(xb, W, rsx, big, smem);
    } break;
    case 1:
    case 11: if (PM(1)) {
      const u16* W = (const u16*)(ws + (st == 1 ? W_D1 : W_D2));
      gemm_f32_phase(big, DFF, DFF, W, y, 11, smem);
    } break;
    case 2: if (PM(2)) row_update(p, 1, 0.5f, p.in[7] + l * 1024, false); break;
    case 3: if (PM(3)) {
      const u16* W = (const u16*)(ws + W_IN);
      win_phase(xb, W, rsx, big, smem);
    } break;
    case 4: if (PM(4)) row_prep(p, l); break;
    case 5: if (PM(5)) {
      const int n_q = 129 * 6, n_kv = 257 * 8, n_cv = 520, n_gm = 544;
      bool kvpre = false;
      for (int t = bid; t < n_q + n_kv + n_cv + n_gm; t += nb) {
        int u = t;
        if (u < n_cv) {
          if (PM(18)) conv_item(p, l, u, smem);
        } else if ((u -= n_cv) < n_gm) {
          if (PM(19)) gmlp_item(p, l, u, smem);
        } else if ((u -= n_gm) < n_q) {
          if (PM(17))
          q_tile(big, (const u16*)(ws + W_UQ), (const float*)(ws + B_RSQ), (const f32x2*)(ws + B_ROPE),
                 (u16*)(ws + B_Q), u / 6, u % 6, smem);
        } else {
          u -= n_q;
          const int u2 = u + nb;
          const bool hn = (t + nb) < n_q + n_kv + n_cv + n_gm;
          if (PM(16))
          kv_tile((const u16*)(ws + B_LAT), (const u16*)(ws + W_UKV), (u16*)(ws + B_KN), (u16*)(ws + B_VTP),
                  (u16*)(ws + B_VTS), u >> 3, u & 7, kvpre, hn, u2 >> 3, u2 & 7, smem);
          kvpre = hn;
        }
      }
    } break;
    case 6: if (PM(6)) {
      int* cnt = (int*)(ws + B_CNT) + l + 4 * rep;
      for (;;) {
        if (otid() == 0) *s_item = atomicAdd(cnt, 1);
        __syncthreads();
        const int idx = *s_item;
        __syncthreads();
        if (idx >= 1088) break;
        attn_item(p, idx, smem);
      }
    } break;
    case 7: if (PM(7)) {
      zero_y_sample(y);
      {
        const int bound = 8 * ((129 * 16 + 7) >> 3);
        int i = bid, mt, nt;
        bool have = next_tile(i, nb, bound, 129, 16, mt, nt), pre = false;
        while (have) {
          int i2 = i + nb, mt2 = 0, nt2 = 0;
          const bool hn = next_tile(i2, nb, bound, 129, 16, mt2, nt2);
          merge_tile((const u16*)(ws + B_A), (const u16*)(ws + B_YB), (const u16*)(ws + B_YC), (const u16*)(ws + B_YD),
                     (const u16*)(ws + W_BRA), (const u16*)(ws + W_BRB), (const u16*)(ws + W_BRC),
                     (const u16*)(ws + W_BRD), big, (u16*)(ws + B_MG), mt, nt, pre, hn, mt2, nt2, smem);
          pre = hn; i = i2; mt = mt2; nt = nt2; have = hn;
        }
      }
    } break;
    case 8: if (PM(8)) {
      gemm_f32_phase((const u16*)(ws + B_MG), 1024, 1024, (const u16*)(ws + W_O), y, 4, smem);
    } break;
    case 9: if (PM(2)) row_update(p, 1, 1.0f, p.in[11] + l * 1024, false); break;
    case 12:
      if (PM(2)) row_update(p, 1, 0.5f, p.in[32] + l * 1024, l == 3);
      if (PM(12)) if (l + 1 < 4) convert_layer(p, l + 1, smem);
      break;
    default: break;
  }
}

constexpr int NPHASES = 1 + 13 * 4;

__global__ void __launch_bounds__(256, 2) mega(Params p, int ph0, int ph1) {
  __shared__ __attribute__((aligned(16))) char smem[65536];
  __shared__ u32x4 s_misc;
  cg::grid_group grid = cg::this_grid();
  if (threadIdx.x == 0) s_misc = u32x4{0u, 0u, 0u, 0u};
  __syncthreads();
  int* s_item = (int*)&s_misc + 2;
  XcdBarrier xb;
  xb.bar = (unsigned*)(p.ws + B_BAR); xb.x = 0u; xb.st = (volatile LAS unsigned*)&s_misc;
  for (int ph = ph0; ph < ph1; ++ph) {
    int reps = 1;
#ifdef DUPMASK
    if (ph > 0 && ((DUPMASK >> ((ph - 1) % 13)) & 1)) reps = 2;
#endif
    for (int rep = 0; rep < reps; ++rep) run_phase(p, ph, smem, s_item, rep);
    if (ph + 1 < ph1) {
      if (ph == ph0) {
        grid.sync();
        xb = xcd_barrier_post((unsigned*)(p.ws + B_BAR), (volatile LAS unsigned*)&s_misc);
      } else {
        xcd_barrier(xb);
      }
    }
  }
}

extern "C" void kernel_launch(void* const* d_in, const int* in_sizes, int n_in, void* d_out, int out_size, void* d_ws,
                              size_t ws_size, hipStream_t stream) {
  (void)in_sizes; (void)n_in; (void)out_size;
  if (ws_size < WS_NEED) { fprintf(stderr, "ws too small: %zu < %zu\n", ws_size, (size_t)WS_NEED); return; }
  static int grid_blocks = 0;
  if (!grid_blocks) {
    int dev = 0, cus = 0, per_cu = 0;
    hipGetDevice(&dev);
    hipDeviceGetAttribute(&cus, hipDeviceAttributeMultiprocessorCount, dev);
    hipOccupancyMaxActiveBlocksPerMultiprocessor(&per_cu, mega, 256, 0);
    if (per_cu < 1) per_cu = 1;
    if (per_cu > 2) per_cu = 2;
    grid_blocks = cus * per_cu;
  }
  Params p{};
  for (int i = 0; i < 35; ++i) p.in[i] = (const float*)d_in[i];
  p.out = (float*)d_out;
  p.ws = (char*)d_ws;
#if COOP
  int ph0 = 0, ph1 = NPHASES;
  void* args[] = {&p, &ph0, &ph1};
  hipError_t e = hipLaunchCooperativeKernel((void*)mega, dim3(grid_blocks), dim3(256), args, 0, stream);
  if (e != hipSuccess) fprintf(stderr, "cooperative launch failed: %s (grid %d)\n", hipGetErrorString(e), grid_blocks);
#else
  for (int ph = 0; ph < NPHASES; ++ph) mega<<<dim3(grid_blocks), dim3(256), 0, stream>>>(p, ph, ph + 1);
#endif
}
```
